# Optimizing an MI355X kernel written in HIP

```python
import math
import jax
import jax.numpy as jnp
from jax import lax
import numpy as np

D_MODEL = 1024
BATCH = 8
SEQ = 4096
DEPTH = 2

GRID_W = 64
CTX_LEN = 256
N_SUB = 3
N_MOD = 3 * N_SUB
D_FF = 2816
FFN_RES = 0.5
NORM_EPS = 1e-6

CHUNK = 128
D_A = 768
A_GROUPS = 6
A_GROUP_DIM = D_A // A_GROUPS

D_B = D_MODEL - D_A
S5_GROUP = 16
S5_GROUPS = D_B // S5_GROUP
S5_STATE = 64
N_DIR = 2

N_HEADS = 8
N_KV_HEADS = 2
HEAD_DIM = D_MODEL // N_HEADS
Q_PER_KV = N_HEADS // N_KV_HEADS
Q_DIM = N_HEADS * HEAD_DIM
KV_DIM = N_KV_HEADS * HEAD_DIM
ROPE_AXIS_DIM = HEAD_DIM // 2
ROPE_HALF = ROPE_AXIS_DIM // 2
ROPE_THETA = 10000.0
Q_BLOCK = 128

N_EVEN = (DEPTH + 1) // 2
N_ODD = DEPTH // 2

kernel_name = "hybrid_sgu_s5_gqa_prefix_dit_block"


def _rms(x, g):
    xf = x.astype(jnp.float32)
    y = xf * lax.rsqrt(jnp.mean(xf * xf, axis=-1, keepdims=True) + NORM_EPS)
    return (y * g.astype(jnp.float32)).astype(x.dtype)


def _modulate_pre(x, g, shift, scale):
    return _rms(x, g) * (1 + scale[:, None]) + shift[:, None]


def _gated_post(x, y, g, gate, weight):
    return x + weight * gate[:, None] * _rms(y, g)


def _swiglu_sub(x, mod, j, g_pre, g_post, w_in, w_out):
    h = _modulate_pre(x, g_pre, mod[:, 3 * j], mod[:, 3 * j + 1])
    gate, up = jnp.split(h @ w_in, 2, axis=-1)
    y = (jax.nn.silu(gate) * up) @ w_out
    return _gated_post(x, y, g_post, mod[:, 3 * j + 2], FFN_RES)


def _chunk_sgu(p, norm_g, w_s, b_s):
    bsz, t, _ = p.shape
    u = jax.nn.gelu(p[..., :D_A])
    v = jax.nn.gelu(p[..., D_A:]).reshape(bsz, t // CHUNK, CHUNK, A_GROUPS, A_GROUP_DIM)
    vf = v.astype(jnp.float32)
    mu = jnp.mean(vf, axis=-1, keepdims=True)
    var = jnp.mean(jnp.square(vf - mu), axis=-1, keepdims=True)
    vn = ((vf - mu) * lax.rsqrt(var + NORM_EPS)
          * norm_g.reshape(A_GROUPS, A_GROUP_DIM).astype(jnp.float32)).astype(p.dtype)
    mixed = jnp.einsum('gts,bnsgc->bntgc', w_s, vn) + b_s.T[:, :, None]
    return u * mixed.reshape(bsz, t, D_A)


def _s5_discretise(lam_re, lam_im, log_step, b_re, b_im, c_re, c_im):
    f32 = jnp.float32
    lam = lax.complex(lam_re.astype(f32), lam_im.astype(f32))
    dt = jnp.exp(log_step.astype(f32))[..., None]
    lam_bar = jnp.exp(lam * dt)
    b_mat = lax.complex(b_re.astype(f32), b_im.astype(f32))
    b_bar = ((lam_bar - 1.0) / lam)[..., None] * b_mat
    c_mat = lax.complex(c_re.astype(f32), c_im.astype(f32))
    return lam_bar, b_bar, c_mat


def _ssm_combine(left, right):
    a_l, h_l = left
    a_r, h_r = right
    return a_l * a_r, a_r * h_l + h_r


def _s5_states(u, lam_bar, b_bar, h0, reverse):
    bu = jnp.einsum('btgc,gpc->btgp', u.astype(jnp.complex64), b_bar)
    if h0 is not None:
        edge = -1 if reverse else 0
        bu = bu.at[:, edge].add(lam_bar * h0)
    a = jnp.broadcast_to(lam_bar, (1,) + bu.shape[1:])
    _, h = lax.associative_scan(_ssm_combine, (a, bu), reverse=reverse, axis=1)
    return h


def _s5_readout(u, h_f, h_b, c_mat, d_skip, glu_w, glu_b, dtype):
    y = (jnp.real(jnp.einsum('btgp,gcp->btgc', h_f, c_mat[0]))
         + jnp.real(jnp.einsum('btgp,gcp->btgc', h_b, c_mat[1])))
    y = y.reshape(*y.shape[:2], D_B) + d_skip.astype(jnp.float32) * u.reshape(*u.shape[:2], D_B)
    y = jax.nn.gelu(y).astype(dtype)
    return y * jax.nn.sigmoid(y @ glu_w + glu_b)


def _mixer_sgu_s5(hl, hc, need_ctx, w_in, w_out, sgu_g, sgu_w, sgu_b, lam_re, lam_im, log_step,
                  b_re, b_im, c_re, c_im, d_skip, glu_w, glu_b):
    lam_bar, b_bar, c_mat = _s5_discretise(lam_re, lam_im, log_step, b_re, b_im, c_re, c_im)
    pl = hl @ w_in
    pc = hc @ w_in

    def s5_in(p):
        return p[..., 2 * D_A:].astype(jnp.float32).reshape(*p.shape[:2], S5_GROUPS, S5_GROUP)

    uc, ul = s5_in(pc), s5_in(pl)
    hc_f = _s5_states(uc, lam_bar[0], b_bar[0], None, False)
    hc_b = _s5_states(uc, lam_bar[1], b_bar[1], None, True)
    hl_f = _s5_states(ul, lam_bar[0], b_bar[0], hc_f[:, -1], False)
    hl_b = _s5_states(ul, lam_bar[1], b_bar[1], hc_b[:, 0], True)

    def merge(p, u, h_f, h_b):
        ya = _chunk_sgu(p[..., :2 * D_A], sgu_g, sgu_w, sgu_b)
        yb = _s5_readout(u, h_f, h_b, c_mat, d_skip, glu_w, glu_b, p.dtype)
        return jnp.concatenate([ya, yb], axis=-1) @ w_out

    yl = merge(pl, ul, hl_f, hl_b)
    yc = merge(pc, uc, hc_f, hc_b) if need_ctx else None
    return yl, yc


def _rope_tables(rows):
    f32 = jnp.float32
    row_id = jnp.repeat(jnp.arange(rows, dtype=f32), GRID_W)
    col_id = jnp.tile(jnp.arange(GRID_W, dtype=f32), rows)
    inv_freq = ROPE_THETA ** (-jnp.arange(0, ROPE_AXIS_DIM, 2, dtype=f32) / ROPE_AXIS_DIM)
    ang = jnp.stack([row_id[:, None] * inv_freq, col_id[:, None] * inv_freq], axis=1)
    return jnp.cos(ang), jnp.sin(ang)


def _rope2d(x, cos, sin):
    xf = x.astype(jnp.float32).reshape(*x.shape[:-1], 2, 2, ROPE_HALF)
    x1, x2 = xf[..., 0, :], xf[..., 1, :]
    c = cos[None, :, None]
    s = sin[None, :, None]
    out = jnp.stack([x1 * c - x2 * s, x2 * c + x1 * s], axis=-2)
    return out.reshape(x.shape).astype(x.dtype)


def _heads(p, n):
    return p.reshape(*p.shape[:2], n, HEAD_DIM)


def _attend(q, k, v):
    bsz, t = q.shape[:2]
    nb = t // Q_BLOCK
    qb = q.reshape(bsz, nb, Q_BLOCK, N_KV_HEADS, Q_PER_KV, HEAD_DIM).transpose(1, 0, 2, 3, 4, 5)
    scale = HEAD_DIM ** -0.5

    def one_block(qi):
        s = jnp.einsum('bqkgd,blkd->bkgql', qi, k).astype(jnp.float32) * scale
        pr = jax.nn.softmax(s, axis=-1).astype(v.dtype)
        return jnp.einsum('bkgql,blkd->bqkgd', pr, v)

    o = lax.map(one_block, qb)
    return o.transpose(1, 0, 2, 3, 4, 5).reshape(bsz, t, Q_DIM)


def _mixer_gqa(hl, hc, need_ctx, w_qkv, w_out, q_g, k_g, cos, sin):
    pkv_c = hc @ w_qkv[:, Q_DIM:]
    kc = _rms(_heads(pkv_c[..., :KV_DIM], N_KV_HEADS), k_g)
    vc = _heads(pkv_c[..., KV_DIM:], N_KV_HEADS)
    pl = hl @ w_qkv
    ql = _rope2d(_rms(_heads(pl[..., :Q_DIM], N_HEADS), q_g), cos, sin)
    kl = _rope2d(_rms(_heads(pl[..., Q_DIM:Q_DIM + KV_DIM], N_KV_HEADS), k_g), cos, sin)
    vl = _heads(pl[..., Q_DIM + KV_DIM:], N_KV_HEADS)
    yl = _attend(ql, jnp.concatenate([kc, kl], axis=1), jnp.concatenate([vc, vl], axis=1)) @ w_out
    yc = None
    if need_ctx:
        qc = _rms(_heads(hc @ w_qkv[:, :Q_DIM], N_HEADS), q_g)
        yc = _attend(qc, kc, vc) @ w_out
    return yl, yc


def setup_inputs(seed: int = 0) -> dict:
    key = jax.random.key(seed)
    ks = iter(jax.random.split(key, 40))
    f32 = jnp.float32

    def nrm(shape, scale):
        return scale * jax.random.normal(next(ks), shape, f32)

    x = nrm((BATCH, SEQ, D_MODEL), 1.0)
    c = nrm((BATCH, D_MODEL), 1.0)
    ctx = nrm((BATCH, CTX_LEN, D_MODEL), 1.0)
    c_ctx = nrm((D_MODEL,), 1.0)
    w_mod = nrm((DEPTH, D_MODEL, N_MOD * D_MODEL), 0.5 * D_MODEL ** -0.5)
    b_mod = nrm((DEPTH, N_MOD * D_MODEL), 0.02)
    norm_pre = 1.0 + nrm((DEPTH, N_SUB, D_MODEL), 0.02)
    norm_post = 1.0 + nrm((DEPTH, N_SUB, D_MODEL), 0.02)
    ffn_w_in = nrm((DEPTH, 2, D_MODEL, 2 * D_FF), D_MODEL ** -0.5)
    ffn_w_out = nrm((DEPTH, 2, D_FF, D_MODEL), D_FF ** -0.5)
    ab_w_in = nrm((N_EVEN, D_MODEL, 2 * D_A + D_B), D_MODEL ** -0.5)
    ab_w_out = nrm((N_EVEN, D_A + D_B, D_MODEL), (D_A + D_B) ** -0.5)
    sgu_norm_g = 1.0 + nrm((N_EVEN, D_A), 0.02)
    sgu_w = nrm((N_EVEN, A_GROUPS, CHUNK, CHUNK), CHUNK ** -0.5)
    sgu_b = 1.0 + nrm((N_EVEN, A_GROUPS, CHUNK), 0.02)
    s5_lam_re = -0.5 * jnp.exp(nrm((N_EVEN, N_DIR, S5_GROUPS, S5_STATE), 0.05))
    s5_lam_im = (math.pi * jnp.arange(S5_STATE, dtype=f32)
                 + nrm((N_EVEN, N_DIR, S5_GROUPS, S5_STATE), 0.01))
    s5_log_step = jax.random.uniform(next(ks), (N_EVEN, N_DIR, S5_GROUPS), f32,
                                     minval=math.log(1e-3), maxval=math.log(1e-1))
    s5_b_re = nrm((N_EVEN, N_DIR, S5_GROUPS, S5_STATE, S5_GROUP), (2 * S5_GROUP) ** -0.5)
    s5_b_im = nrm((N_EVEN, N_DIR, S5_GROUPS, S5_STATE, S5_GROUP), (2 * S5_GROUP) ** -0.5)
    s5_c_re = nrm((N_EVEN, N_DIR, S5_GROUPS, S5_GROUP, S5_STATE), (2 * S5_STATE) ** -0.5)
    s5_c_im = nrm((N_EVEN, N_DIR, S5_GROUPS, S5_GROUP, S5_STATE), (2 * S5_STATE) ** -0.5)
    s5_d = nrm((N_EVEN, D_B), 1.0)
    s5_glu_w = nrm((N_EVEN, D_B, D_B), D_B ** -0.5)
    s5_glu_b = nrm((N_EVEN, D_B), 0.02)
    attn_w_qkv = nrm((N_ODD, D_MODEL, Q_DIM + 2 * KV_DIM), D_MODEL ** -0.5)
    attn_w_out = nrm((N_ODD, Q_DIM, D_MODEL), Q_DIM ** -0.5)
    attn_q_norm = 1.0 + nrm((N_ODD, HEAD_DIM), 0.02)
    attn_k_norm = 1.0 + nrm((N_ODD, HEAD_DIM), 0.02)
    return {"x": x, "c": c, "ctx": ctx, "c_ctx": c_ctx, "w_mod": w_mod, "b_mod": b_mod,
            "norm_pre": norm_pre, "norm_post": norm_post, "ffn_w_in": ffn_w_in, "ffn_w_out": ffn_w_out,
            "ab_w_in": ab_w_in, "ab_w_out": ab_w_out, "sgu_norm_g": sgu_norm_g, "sgu_w": sgu_w,
            "sgu_b": sgu_b, "s5_lam_re": s5_lam_re, "s5_lam_im": s5_lam_im, "s5_log_step": s5_log_step,
            "s5_b_re": s5_b_re, "s5_b_im": s5_b_im, "s5_c_re": s5_c_re, "s5_c_im": s5_c_im,
            "s5_d": s5_d, "s5_glu_w": s5_glu_w, "s5_glu_b": s5_glu_b, "attn_w_qkv": attn_w_qkv,
            "attn_w_out": attn_w_out, "attn_q_norm": attn_q_norm, "attn_k_norm": attn_k_norm}


def reference(x, c, ctx, c_ctx, w_mod, b_mod, norm_pre, norm_post, ffn_w_in, ffn_w_out,
              ab_w_in, ab_w_out, sgu_norm_g, sgu_w, sgu_b, s5_lam_re, s5_lam_im, s5_log_step,
              s5_b_re, s5_b_im, s5_c_re, s5_c_im, s5_d, s5_glu_w, s5_glu_b,
              attn_w_qkv, attn_w_out, attn_q_norm, attn_k_norm):
    rows = x.shape[1] // GRID_W
    cos, sin = _rope_tables(rows)
    cond_l = jax.nn.silu(c)
    cond_c = jax.nn.silu(c_ctx)[None]
    xl, xc = x, ctx
    for i in range(DEPTH):
        last = i == DEPTH - 1
        j = i // 2
        mod_l = (cond_l @ w_mod[i] + b_mod[i]).reshape(-1, N_MOD, D_MODEL)
        mod_c = (cond_c @ w_mod[i] + b_mod[i]).reshape(-1, N_MOD, D_MODEL)
        ffn1 = (norm_pre[i, 0], norm_post[i, 0], ffn_w_in[i, 0], ffn_w_out[i, 0])
        ffn2 = (norm_pre[i, 2], norm_post[i, 2], ffn_w_in[i, 1], ffn_w_out[i, 1])
        xl = _swiglu_sub(xl, mod_l, 0, *ffn1)
        xc = _swiglu_sub(xc, mod_c, 0, *ffn1)
        hl = _modulate_pre(xl, norm_pre[i, 1], mod_l[:, 3], mod_l[:, 4])
        hc = _modulate_pre(xc, norm_pre[i, 1], mod_c[:, 3], mod_c[:, 4])
        if i % 2 == 0:
            yl, yc = _mixer_sgu_s5(hl, hc, not last, ab_w_in[j], ab_w_out[j], sgu_norm_g[j], sgu_w[j],
                                   sgu_b[j], s5_lam_re[j], s5_lam_im[j], s5_log_step[j], s5_b_re[j],
                                   s5_b_im[j], s5_c_re[j], s5_c_im[j], s5_d[j], s5_glu_w[j], s5_glu_b[j])
        else:
            yl, yc = _mixer_gqa(hl, hc, not last, attn_w_qkv[j], attn_w_out[j], attn_q_norm[j],
                                attn_k_norm[j], cos, sin)
        xl = _gated_post(xl, yl, norm_post[i, 1], mod_l[:, 5], 1.0)
        xl = _swiglu_sub(xl, mod_l, 2, *ffn2)
        if not last:
            xc = _gated_post(xc, yc, norm_post[i, 1], mod_c[:, 5], 1.0)
            xc = _swiglu_sub(xc, mod_c, 2, *ffn2)
    return xl
```

```cpp
#include <hip/hip_runtime.h>
#include <hip/hip_cooperative_groups.h>
#include <cstdio>
#include <cstdint>
namespace cg = cooperative_groups;

#ifndef MK_PER_PHASE
#define MK_PER_PHASE 0
#endif

#define LAS __attribute__((address_space(3)))
typedef unsigned short bf16_t;
typedef short bf16x8 __attribute__((ext_vector_type(8)));
typedef short s16x4 __attribute__((ext_vector_type(4)));
typedef float f32x2 __attribute__((ext_vector_type(2)));
typedef float f32x4 __attribute__((ext_vector_type(4)));
typedef float f32x16 __attribute__((ext_vector_type(16)));
typedef unsigned u32x2 __attribute__((ext_vector_type(2)));
typedef unsigned u32x4 __attribute__((ext_vector_type(4)));
typedef _Float16 f16x4 __attribute__((ext_vector_type(4)));

constexpr int DM = 1024, NB = 8, SEQ = 4096, CTXL = 256, RPB = SEQ + CTXL, MR = NB * RPB;
constexpr int DFF = 2816, NMODV = 9 * DM;
constexpr int DA = 768, DB = 256, NAB = 2 * DA + DB;
constexpr int NQKV = 1536;
constexpr int NCH = MR / 16, NCHP = 2304, CPB = RPB / 16;
constexpr float EPS = 1e-6f;

constexpr size_t al256(size_t x) { return (x + 255) / 256 * 256; }
constexpr size_t SZ_WFI = (size_t)2 * DFF * DM * 2, SZ_WFO = (size_t)DM * DFF * 2;
constexpr size_t WS_WFI = 0;
constexpr size_t WS_WFO = WS_WFI + 4 * SZ_WFI;
constexpr size_t WS_WABI = WS_WFO + 4 * SZ_WFO;
constexpr size_t WS_WABO = WS_WABI + (size_t)NAB * DM * 2;
constexpr size_t WS_WQKV = WS_WABO + (size_t)DM * DM * 2;
constexpr size_t WS_WAO = WS_WQKV + (size_t)NQKV * DM * 2;
constexpr size_t WS_WGLU = WS_WAO + (size_t)DM * DM * 2;
constexpr size_t WS_WSGU = WS_WGLU + (size_t)DB * DB * 2;
constexpr size_t WS_B1 = WS_WSGU + (size_t)6 * 128 * 128 * 2;
constexpr size_t WS_B2 = WS_B1 + (size_t)16 * 256 * 256 * 2;
constexpr size_t WS_MOD = WS_B2 + (size_t)16 * 256 * 512 * 2;
constexpr size_t WS_ROPE = WS_MOD + al256((size_t)2 * 9 * NMODV * 4);
constexpr size_t WS_XC = WS_ROPE + (size_t)2 * 2048 * 4;
constexpr size_t WS_H = WS_XC + (size_t)MR * DM * 2;
constexpr size_t WS_BIG = WS_H + (size_t)MR * DM * 2;
constexpr size_t WS_Y = WS_BIG + (size_t)MR * DFF * 2;
constexpr size_t WS_S = WS_Y + (size_t)MR * DM * 2;
constexpr size_t WS_END = WS_S + (size_t)16 * NCHP * 256 * 4;
constexpr size_t WS_A2 = WS_Y, WS_YB = WS_A2 + (size_t)16 * NCHP * 512 * 2;
static_assert(WS_YB + (size_t)MR * DB * 2 <= WS_S, "A2 + YB inside Y");
constexpr size_t WS_KB = WS_S, WS_VB = WS_KB + (size_t)NB * 2 * RPB * 128 * 2;
static_assert(WS_VB + (size_t)NB * 2 * RPB * 128 * 2 <= WS_END, "KB + VB inside S");

constexpr size_t WS_BAR = WS_END;
constexpr size_t WS_TOTAL = WS_END + 16384;
static_assert(WS_TOTAL <= (size_t)4 * NB * SEQ * DM * 4, "workspace map must fit in 4x the largest tensor");
constexpr int LDS_BYTES = 147456;

__device__ __forceinline__ unsigned cvt_pk_bf16(float lo, float hi) { unsigned r; asm volatile("v_cvt_pk_bf16_f32 %0, %1, %2" : "=v"(r) : "v"(lo), "v"(hi)); return r; }
__device__ __forceinline__ float bf2f(unsigned short b) { return __uint_as_float((unsigned)b << 16); }
__device__ __forceinline__ float bflo(unsigned w) { return __uint_as_float(w << 16); }
__device__ __forceinline__ float bfhi(unsigned w) { return __uint_as_float(w & 0xffff0000u); }
__device__ __forceinline__ float gelu_tanh(float x) { const float z = x * x * (0.044715f * 2.302208198f) + 2.302208198f;   return x * __builtin_amdgcn_rcpf(1.f + __builtin_amdgcn_exp2f(-x * z)); }
__device__ __forceinline__ float silu_f(float x) { return x * __builtin_amdgcn_rcpf(1.f + __builtin_amdgcn_exp2f(-1.4426950408889634f * x)); }
__device__ __forceinline__ float sigmoid_f(float x) { return __builtin_amdgcn_rcpf(1.f + __builtin_amdgcn_exp2f(-1.4426950408889634f * x)); }
__device__ __forceinline__ float wave_sum(float v) {
#pragma unroll
    for (int o = 1; o < 64; o <<= 1) v += __shfl_xor(v, o);
    return v;
}
#define LDS_WAIT() asm volatile("s_waitcnt lgkmcnt(0)" ::: "memory")
__device__ __forceinline__ int get_tid(int wave_s) { int l; asm volatile("v_mbcnt_lo_u32_b32 %0, -1, 0\n\tv_mbcnt_hi_u32_b32 %0, -1, %0" : "=v"(l)); return wave_s * 64 + l; }

namespace pg8 {
constexpr int BM = 256, BK = 64, HALF = 128, HTB = HALF * BK * 2, STAGE_BYTES = 8 * HTB, NXCD = 8, WGM = 8;
__host__ __device__ __forceinline__ int lds_byte(int r, int c) { const int st = (r >> 4) * 2 + (c >> 5), rr = r & 15, cc = c & 31, ob = rr * 64 + cc * 2; return st * 1024 + (ob ^ (((ob >> 9) & 1) << 5)); }
__host__ __device__ __forceinline__ void stage_rc(int b, int& R, int& C) { const int st = b / 1024, sb = b % 1024, swz = sb ^ (((sb >> 9) & 1) << 5); R = (st >> 1) * 16 + swz / 64; C = (st & 1) * 32 + (swz % 64) / 2; }
__host__ __device__ __forceinline__ int perm32(int rho) { const int n = rho >> 4, i = rho & 15; return 8 * (i >> 2) + 4 * n + (i & 3); }

struct Unit { int pm, pn; };
struct Gemm { const bf16_t* A; const bf16_t* Bt; int lda, ldb, K; };

struct Order {
    int nM, nN, nwg, G, c, kind;
    __device__ void init(int nM_, int nN_, int G_, int c_, int kind_) { nM = nM_; nN = nN_; nwg = nM * nN; G = G_; c = c_; kind = kind_; }
    __device__ bool next(int i, Unit& u) const {
        const long L = (long)i * G + c; if (L >= nwg) return false;
        if (kind == 2) { u.pm = (int)L; u.pn = (int)L / 9; return true; }
        int wgid = (int)L; { const int q = nwg / NXCD, r = nwg % NXCD, xcd = wgid % NXCD, off = wgid / NXCD; wgid = (xcd < r ? xcd * (q + 1) : r * (q + 1) + (xcd - r) * q) + off; }
        const int nig = WGM * nN, gid = wgid / nig, fm = gid * WGM, gsz = (nM - fm) < WGM ? (nM - fm) : WGM;
        int pm = fm + ((wgid % nig) % gsz); u.pn = (wgid % nig) / gsz;
        if (kind == 1) pm = pm + (pm >> 4) + 1;
        u.pm = pm; return true;
    }
};

enum { EM_BF16 = 0, EM_SWIGLU = 1, EM_ABIN = 2, EM_S5G1 = 3, EM_S5G2 = 4, EM_GLU = 5 };
struct Epi {
    static constexpr bool PERM = true;
    int mode; bf16_t* O; int ldc; bf16_t* O2; const bf16_t* aux; const float* bias; float* Of;
    __device__ __forceinline__ void operator()(const f32x4 (&acc)[2][2][4][2], const Unit& u, int wr, int wc, int fr, int fq) const {
        const int row0 = u.pm * BM + wr * 64 + fr, cw = wc * 32 + 8 * fq;
        if (mode == EM_BF16 || (mode == EM_ABIN && u.pn < 6)) {
#pragma unroll
            for (int ai = 0; ai < 2; ++ai)
#pragma unroll
                for (int m = 0; m < 4; ++m) { bf16_t* rowp = O + (size_t)(row0 + ai * HALF + m * 16) * ldc + u.pn * BM + cw;
#pragma unroll
                    for (int bj = 0; bj < 2; ++bj) { const f32x4 v0 = acc[ai][bj][m][0], v1 = acc[ai][bj][m][1];
                        u32x4 w; w.x = cvt_pk_bf16(v0[0], v0[1]); w.y = cvt_pk_bf16(v0[2], v0[3]); w.z = cvt_pk_bf16(v1[0], v1[1]); w.w = cvt_pk_bf16(v1[2], v1[3]);
                        *(u32x4*)(rowp + bj * HALF) = w; } }
        } else if (mode == EM_SWIGLU) {
#pragma unroll
            for (int ai = 0; ai < 2; ++ai)
#pragma unroll
                for (int m = 0; m < 4; ++m) { bf16_t* rowp = O + (size_t)(row0 + ai * HALF + m * 16) * ldc + u.pn * HALF + cw;
                    float r[8];
#pragma unroll
                    for (int n = 0; n < 2; ++n)
#pragma unroll
                        for (int j = 0; j < 4; ++j) r[n * 4 + j] = silu_f(acc[ai][0][m][n][j]) * acc[ai][1][m][n][j];
                    u32x4 w; w.x = cvt_pk_bf16(r[0], r[1]); w.y = cvt_pk_bf16(r[2], r[3]); w.z = cvt_pk_bf16(r[4], r[5]); w.w = cvt_pk_bf16(r[6], r[7]);
                    *(u32x4*)rowp = w; }
        } else if (mode == EM_ABIN) {
#pragma unroll
            for (int ai = 0; ai < 2; ++ai)
#pragma unroll
                for (int m = 0; m < 4; ++m) { const int R = row0 + ai * HALF + m * 16;
#pragma unroll
                    for (int bj = 0; bj < 2; ++bj) { const int col = bj * HALF + cw, g = col >> 4, c0 = col & 15; const f32x4 v0 = acc[ai][bj][m][0], v1 = acc[ai][bj][m][1];
                        u32x4 w; w.x = cvt_pk_bf16(v0[0], v0[1]); w.y = cvt_pk_bf16(v0[2], v0[3]); w.z = cvt_pk_bf16(v1[0], v1[1]); w.w = cvt_pk_bf16(v1[2], v1[3]);
                        *(u32x4*)(O2 + ((size_t)(g * NCHP + (R >> 4)) * 512 + (R & 15) * 16 + c0)) = w; } }
        } else if (mode == EM_S5G1) {
#pragma unroll
            for (int ai = 0; ai < 2; ++ai)
#pragma unroll
                for (int m = 0; m < 4; ++m) { float* rowp = Of + (size_t)(row0 + ai * HALF + m * 16) * 256 + cw;
#pragma unroll
                    for (int bj = 0; bj < 2; ++bj) { *(f32x4*)(rowp + bj * HALF) = acc[ai][bj][m][0]; *(f32x4*)(rowp + bj * HALF + 4) = acc[ai][bj][m][1]; } }
        } else if (mode == EM_S5G2) {
            const int g = u.pn;
#pragma unroll
            for (int ai = 0; ai < 2; ++ai)
#pragma unroll
                for (int m = 0; m < 4; ++m) { const int ch = row0 + ai * HALF + m * 16 - g * NCHP;
                    if (ch < NCH) {
#pragma unroll
                        for (int bj = 0; bj < 2; ++bj) { const int col = bj * HALF + cw, t = col >> 4, c0 = col & 15; const f32x4 v0 = acc[ai][bj][m][0], v1 = acc[ai][bj][m][1];
                            u32x4 w; w.x = cvt_pk_bf16(gelu_tanh(v0[0]), gelu_tanh(v0[1])); w.y = cvt_pk_bf16(gelu_tanh(v0[2]), gelu_tanh(v0[3]));
                            w.z = cvt_pk_bf16(gelu_tanh(v1[0]), gelu_tanh(v1[1])); w.w = cvt_pk_bf16(gelu_tanh(v1[2]), gelu_tanh(v1[3]));
                            *(u32x4*)(O + ((size_t)(ch * 16 + t) * DB + g * 16 + c0)) = w; } } }
        } else {
#pragma unroll
            for (int ai = 0; ai < 2; ++ai)
#pragma unroll
                for (int m = 0; m < 4; ++m) { const size_t R = (size_t)(row0 + ai * HALF + m * 16);
#pragma unroll
                    for (int bj = 0; bj < 2; ++bj) { const int col = bj * HALF + cw; const f32x4 v0 = acc[ai][bj][m][0], v1 = acc[ai][bj][m][1];
                        const u32x4 y = *(const u32x4*)(aux + R * DB + col); const f32x4 b0 = *(const f32x4*)(bias + col), b1 = *(const f32x4*)(bias + col + 4);
                        u32x4 w;
                        w.x = cvt_pk_bf16(bflo(y.x) * sigmoid_f(v0[0] + b0[0]), bfhi(y.x) * sigmoid_f(v0[1] + b0[1]));
                        w.y = cvt_pk_bf16(bflo(y.y) * sigmoid_f(v0[2] + b0[2]), bfhi(y.y) * sigmoid_f(v0[3] + b0[3]));
                        w.z = cvt_pk_bf16(bflo(y.z) * sigmoid_f(v1[0] + b1[0]), bfhi(y.z) * sigmoid_f(v1[1] + b1[1]));
                        w.w = cvt_pk_bf16(bflo(y.w) * sigmoid_f(v1[2] + b1[2]), bfhi(y.w) * sigmoid_f(v1[3] + b1[3]));
                        *(u32x4*)(O2 + R * DM + DA + col) = w; } }
        }
    }
};

template <class Cfg>
__device__ __forceinline__ void gemm_phase(LAS unsigned char* lds, const Cfg cfg) {
    Gemm g; { Order S0; Epi E0; cfg.get(g, S0, E0); }
#define PG8_NEXT(i_, u_) ({ Cfg c2 = cfg; c2.opaque(); Gemm g2; Order S2; Epi E2; c2.get(g2, S2, E2); S2.next(i_, u_); })
    const int tid = get_tid(cfg.wave_s), wid = __builtin_amdgcn_readfirstlane(tid >> 6), lane = tid & 63, wr = wid >> 2, wc = wid & 3, fr = lane & 15, fq = lane >> 4;
    const int K = g.K, nt = K / BK;
    unsigned voffA[2], voffB[2];
#pragma unroll
    for (int i = 0; i < 2; ++i) { int R, C; stage_rc(tid * 16 + i * 8192, R, C); const int Rb = Epi::PERM ? ((R & ~31) + perm32(R & 31)) : R;
        voffA[i] = (unsigned)(R * g.lda + C) * 2u; voffB[i] = (unsigned)(Rb * g.ldb + C) * 2u; }
    const size_t kstep = (size_t)(BK * 2);
    const size_t hstepA = (size_t)HALF * g.lda * 2, hstepB = (size_t)HALF * g.ldb * 2;
    const size_t tstepA = 2 * hstepA, tstepB = 2 * hstepB;
    const unsigned ldsw = (unsigned)wid * 1024u;
    const int aoff = lds_byte(wr * 64 + fr, fq * 8), boff = lds_byte(wc * 32 + fr, fq * 8);
#define PG8_SA(b, h) (((b) * 2 + (h)) * HTB)
#define PG8_SB(b, h) ((4 + (b) * 2 + (h)) * HTB)
#define PG8_STAGE(bufoff, gbase, voff) do { _Pragma("unroll") for (int _i = 0; _i < 2; ++_i) \
        __builtin_amdgcn_global_load_lds((const unsigned*)((const char*)(gbase) + (voff)[_i]), (LAS unsigned*)(lds + (bufoff) + ldsw + _i * 8192), 16, 0, 0); } while (0)
#define PG8_LDA(dst, b, h) do { _Pragma("unroll") for (int m = 0; m < 4; ++m) _Pragma("unroll") for (int k = 0; k < 2; ++k) dst[m][k] = *(const LAS bf16x8*)(lds + PG8_SA(b, h) + aoff + m * 2048 + k * 1024); } while (0)
#define PG8_LDB(dst, b, h) do { _Pragma("unroll") for (int n = 0; n < 2; ++n) _Pragma("unroll") for (int k = 0; k < 2; ++k) dst[n][k] = *(const LAS bf16x8*)(lds + PG8_SB(b, h) + boff + n * 2048 + k * 1024); } while (0)
#define PG8_MMA(ai, bj, At, Bt) do { __builtin_amdgcn_s_setprio(1); _Pragma("unroll") for (int m = 0; m < 4; ++m) _Pragma("unroll") for (int n = 0; n < 2; ++n) _Pragma("unroll") for (int k = 0; k < 2; ++k) \
        acc[ai][bj][m][n] = __builtin_amdgcn_mfma_f32_16x16x32_bf16(Bt[n][k], At[m][k], acc[ai][bj][m][n], 0, 0, 0); __builtin_amdgcn_s_setprio(0); } while (0)
#define PG8_WAIT_V(n) asm volatile("s_waitcnt vmcnt(" #n ")" ::: "memory")
#define PG8_WAIT_L(n) asm volatile("s_waitcnt lgkmcnt(" #n ")" ::: "memory")
#define PG8_BAR __builtin_amdgcn_s_barrier()
#define PG8_SCHED __builtin_amdgcn_sched_barrier(0)
    Unit cur, nxt; int ui = 0;
    if (!PG8_NEXT(0, cur)) return;
    f32x4 acc[2][2][4][2];
#pragma unroll
    for (int a = 0; a < 2; ++a)
#pragma unroll
        for (int b = 0; b < 2; ++b)
#pragma unroll
            for (int m = 0; m < 4; ++m)
#pragma unroll
                for (int n = 0; n < 2; ++n) acc[a][b][m][n] = (f32x4){0.f, 0.f, 0.f, 0.f};
    bf16x8 At[4][2], B0[2][2], B1[2][2];
    const char* cA = (const char*)g.A + (size_t)cur.pm * tstepA; const char* cB = (const char*)g.Bt + (size_t)cur.pn * tstepB;
    PG8_STAGE(PG8_SB(0, 0), cB, voffB); PG8_STAGE(PG8_SB(0, 1), cB + hstepB, voffB); PG8_STAGE(PG8_SA(0, 0), cA, voffA); PG8_STAGE(PG8_SA(0, 1), cA + hstepA, voffA);
    if (wr == 1) PG8_BAR;
    PG8_WAIT_V(2); PG8_BAR;
    PG8_STAGE(PG8_SB(1, 0), cB + kstep, voffB); PG8_STAGE(PG8_SA(1, 0), cA + kstep, voffA); PG8_STAGE(PG8_SB(1, 1), cB + hstepB + kstep, voffB);
    PG8_WAIT_V(6); PG8_BAR;
    for (;;) {
        const bool has_next = PG8_NEXT(ui + 1, nxt);
        const char* nA = has_next ? (const char*)g.A + (size_t)nxt.pm * tstepA : cA; const char* nB = has_next ? (const char*)g.Bt + (size_t)nxt.pn * tstepB : cB;
        for (int t = 0; t < nt; t += 2) {
            const bool last = (t == nt - 2);
            const char* a1 = cA + (size_t)(t + 1) * kstep;
            const char* a2 = last ? nA : cA + (size_t)(t + 2) * kstep; const char* b2 = last ? nB : cB + (size_t)(t + 2) * kstep;
            const char* a3 = a2 + kstep; const char* b3 = b2 + kstep;
            PG8_LDB(B0, 0, 0); PG8_LDB(B1, 0, 1); PG8_SCHED; PG8_LDA(At, 0, 0); PG8_STAGE(PG8_SA(1, 1), a1 + hstepA, voffA);
            PG8_WAIT_V(8); PG8_WAIT_L(0); PG8_BAR; PG8_MMA(0, 0, At, B0); PG8_MMA(0, 1, At, B1); PG8_BAR; PG8_SCHED;
            const bool tail = last && !has_next;
            PG8_LDA(At, 0, 1); if (!tail) { PG8_STAGE(PG8_SB(0, 0), b2, voffB); PG8_STAGE(PG8_SB(0, 1), b2 + hstepB, voffB); PG8_STAGE(PG8_SA(0, 0), a2, voffA); }
            if (tail) PG8_WAIT_V(0); else PG8_WAIT_V(8);
            PG8_WAIT_L(0); PG8_BAR; PG8_MMA(1, 0, At, B0); PG8_MMA(1, 1, At, B1); PG8_BAR; PG8_SCHED;
            PG8_LDB(B0, 1, 0); PG8_LDB(B1, 1, 1); PG8_SCHED; PG8_LDA(At, 1, 0); if (!tail) PG8_STAGE(PG8_SA(0, 1), a2 + hstepA, voffA);
            if (tail) PG8_WAIT_V(0); else PG8_WAIT_V(8);
            PG8_WAIT_L(0); PG8_BAR; PG8_MMA(0, 0, At, B0); PG8_MMA(0, 1, At, B1); PG8_BAR; PG8_SCHED;
            PG8_LDA(At, 1, 1); if (!tail) { PG8_STAGE(PG8_SB(1, 0), b3, voffB); PG8_STAGE(PG8_SB(1, 1), b3 + hstepB, voffB); PG8_STAGE(PG8_SA(1, 0), a3, voffA); }
            if (tail) PG8_WAIT_V(0); else PG8_WAIT_V(8);
            PG8_WAIT_L(0); PG8_BAR; PG8_MMA(1, 0, At, B0); PG8_MMA(1, 1, At, B1); PG8_BAR; PG8_SCHED;
        }
        if (wr == 0) PG8_BAR;
        { Cfg c2 = cfg; c2.opaque(); Gemm g2; Order S2; Epi E2; c2.get(g2, S2, E2); E2(acc, cur, wr, wc, fr, fq); }
        if (!has_next) break;
#pragma unroll
        for (int a = 0; a < 2; ++a)
#pragma unroll
            for (int b = 0; b < 2; ++b)
#pragma unroll
                for (int m = 0; m < 4; ++m)
#pragma unroll
                    for (int n = 0; n < 2; ++n) acc[a][b][m][n] = (f32x4){0.f, 0.f, 0.f, 0.f};
        cur = nxt; cA = nA; cB = nB; ++ui;
        if (wr == 1) PG8_BAR;
    }
    PG8_WAIT_V(0);
    PG8_BAR;
#undef PG8_NEXT
#undef PG8_SA
#undef PG8_SB
#undef PG8_STAGE
#undef PG8_LDA
#undef PG8_LDB
#undef PG8_MMA
#undef PG8_WAIT_V
#undef PG8_WAIT_L
#undef PG8_BAR
#undef PG8_SCHED
}
}

namespace att {
constexpr int D = 128, NW = 8, QBLK = 32, KVBLK = 64;
constexpr float SCALE = 0.088388347648318440f;
constexpr float THR = 8.f;
constexpr int LDQ = NQKV, LDK = 128, LDO = DM;
constexpr size_t SHM_V = KVBLK * D * 2, SHM_K = KVBLK * D * 2, SHM_ATTN = 2 * SHM_V + 2 * SHM_K + NW * 64 * 4;
#define KSWZ(row, colB) ((row) * 256 + ((colB) ^ (((row) & 15) << 4)))
#define SBAR() __builtin_amdgcn_sched_barrier(0)
__device__ __forceinline__ int crow(int r, int hi) { return (r & 3) + 8 * (r >> 2) + 4 * hi; }
__device__ __forceinline__ void partialSM(f32x16& p0) {
#pragma unroll
  for (int r = 0; r < 16; ++r) p0[r] = __builtin_amdgcn_exp2f(p0[r]);
}
__device__ __forceinline__ void finishSM(f32x16& p0, f32x16& p1, float& l_reg, bf16x8& pa0, bf16x8& pa1, bf16x8& pa2, bf16x8& pa3) {
#pragma unroll
  for (int r = 0; r < 16; ++r) p1[r] = __builtin_amdgcn_exp2f(p1[r]);
  float ps = 0;
#pragma unroll
  for (int r = 0; r < 16; ++r) ps += p0[r];
#pragma unroll
  for (int r = 0; r < 16; ++r) ps += p1[r];
  { auto rr = __builtin_amdgcn_permlane32_swap(__float_as_uint(ps), __float_as_uint(ps), false, false);
    ps = __uint_as_float(rr[0]) + __uint_as_float(rr[1]); }
  l_reg += ps;
#define PK4(P, BASE, OUT) do { unsigned a0 = cvt_pk_bf16(P[BASE + 0], P[BASE + 1]), a1 = cvt_pk_bf16(P[BASE + 2], P[BASE + 3]);   \
    unsigned b0 = cvt_pk_bf16(P[BASE + 4], P[BASE + 5]), b1 = cvt_pk_bf16(P[BASE + 6], P[BASE + 7]);                              \
    auto r0 = __builtin_amdgcn_permlane32_swap(a0, b0, false, false); auto r1 = __builtin_amdgcn_permlane32_swap(a1, b1, false, false); \
    u32x4 w = {r0[0], r1[0], r0[1], r1[1]}; OUT = *reinterpret_cast<bf16x8*>(&w); } while (0)
  PK4(p0, 0, pa0); PK4(p0, 8, pa1); PK4(p1, 0, pa2); PK4(p1, 8, pa3);
#undef PK4
}
__device__ __forceinline__ void qkt(f32x16& p0, f32x16& p1, const bf16_t* Ks, const bf16x8* qr, int r32, int hi) {
  p0 = f32x16{}; p1 = f32x16{};
#pragma unroll
  for (int d0 = 0; d0 < 8; ++d0) { int cb = (d0 * 16 + hi * 8) * 2;
    bf16x8 b0 = *reinterpret_cast<const bf16x8*>((const char*)Ks + KSWZ(r32, cb));
    bf16x8 b1 = *reinterpret_cast<const bf16x8*>((const char*)Ks + KSWZ(32 + r32, cb));
    p0 = __builtin_amdgcn_mfma_f32_32x32x16_bf16(b0, qr[d0], p0, 0, 0, 0);
    p1 = __builtin_amdgcn_mfma_f32_32x32x16_bf16(b1, qr[d0], p1, 0, 0, 0); }
}
__device__ __forceinline__ int v_st(int k, int c) { const int kk = (k & ~0xC) | ((k & 4) << 1) | ((k & 8) >> 1); return ((kk >> 3) * 4 + (c >> 5)) * 512 + ((kk & 7) * 32 + (c & 31)) * 2; }
__device__ __forceinline__ int v_rd_base(int lane) { return ((lane & 3) << 3) | (((lane >> 2) & 3) << 6) | (((lane >> 4) & 1) << 5) | (((lane >> 5) & 1) << 8); }
constexpr int v_rd_off(int d0, int ks, int half) { return d0 * 512 + ks * 4096 + half * 2048; }
template <int OFF> __device__ __forceinline__ s16x4 tr_read(int vb) {
  s16x4 r; asm volatile("ds_read_b64_tr_b16 %0, %1 offset:%2" : "=&v"(r) : "v"(vb), "i"(OFF) : "memory"); return r;
}
template <int D0> __device__ __forceinline__ void pv_one(f32x16& od, int vb, bf16x8 pa0, bf16x8 pa1, bf16x8 pa2, bf16x8 pa3) {
  const s16x4 l0 = tr_read<v_rd_off(D0, 0, 0)>(vb), h0 = tr_read<v_rd_off(D0, 0, 1)>(vb), l1 = tr_read<v_rd_off(D0, 1, 0)>(vb), h1 = tr_read<v_rd_off(D0, 1, 1)>(vb);
  const s16x4 l2 = tr_read<v_rd_off(D0, 2, 0)>(vb), h2 = tr_read<v_rd_off(D0, 2, 1)>(vb), l3 = tr_read<v_rd_off(D0, 3, 0)>(vb), h3 = tr_read<v_rd_off(D0, 3, 1)>(vb);
  asm volatile("s_waitcnt lgkmcnt(0)" ::: "memory"); SBAR();
#define PK(L, H) (bf16x8){L[0], L[1], L[2], L[3], H[0], H[1], H[2], H[3]}
  od = __builtin_amdgcn_mfma_f32_32x32x16_bf16(pa0, PK(l0, h0), od, 0, 0, 0);
  od = __builtin_amdgcn_mfma_f32_32x32x16_bf16(pa1, PK(l1, h1), od, 0, 0, 0);
  od = __builtin_amdgcn_mfma_f32_32x32x16_bf16(pa2, PK(l2, h2), od, 0, 0, 0);
  od = __builtin_amdgcn_mfma_f32_32x32x16_bf16(pa3, PK(l3, h3), od, 0, 0, 0);
#undef PK
}
__device__ __forceinline__ void pv_d0(f32x16* o, int vb, bf16x8 pa0, bf16x8 pa1, bf16x8 pa2, bf16x8 pa3) {
  pv_one<0>(o[0], vb, pa0, pa1, pa2, pa3); pv_one<1>(o[1], vb, pa0, pa1, pa2, pa3); pv_one<2>(o[2], vb, pa0, pa1, pa2, pa3); pv_one<3>(o[3], vb, pa0, pa1, pa2, pa3);
}
__device__ __forceinline__ void attn_dense_body(const bf16_t* __restrict__ Qb, const bf16_t* __restrict__ Kh, const bf16_t* __restrict__ Vh,
                                                bf16_t* __restrict__ Ob, int seq, char* lds, int t0, const float* __restrict__ qg, const float* __restrict__ ROPE, int wave_s) {
  const int tid = get_tid(wave_s), wid = tid >> 6, lane = tid & 63, r32 = lane & 31, hi = lane >> 5;
  bf16_t* V_lds = (bf16_t*)lds; bf16_t* K_lds = (bf16_t*)(lds + 2 * SHM_V);
  float* ws = (float*)(lds + 2 * SHM_V + 2 * SHM_K) + wid * 64; float* li_l = ws; float* al_l = ws + 32;
  float l_reg = 0; f32x16 o[4] = {}; bf16x8 qr[8];
  const int sr = tid >> 4, sc = (tid & 15) * 8;
  bf16x8 s0v0, s0v1, s0k0, s0k1, s1v0, s1v1, s1k0, s1k1;
  s0v0 = *reinterpret_cast<const bf16x8*>(&Vh[(long)sr * LDK + sc]); s0v1 = *reinterpret_cast<const bf16x8*>(&Vh[(long)(32 + sr) * LDK + sc]);
  s0k0 = *reinterpret_cast<const bf16x8*>(&Kh[(long)sr * LDK + sc]); s0k1 = *reinterpret_cast<const bf16x8*>(&Kh[(long)(32 + sr) * LDK + sc]);
  {
    const bf16_t* Qw = Qb + (long)(wid * QBLK + r32) * LDQ + hi * 8;
    float qf[8][8]; float ss = 0.f;
#pragma unroll
    for (int d0 = 0; d0 < 8; ++d0) { const u32x4 raw = *reinterpret_cast<const u32x4*>(Qw + d0 * 16);
      qf[d0][0] = bflo(raw.x); qf[d0][1] = bfhi(raw.x); qf[d0][2] = bflo(raw.y); qf[d0][3] = bfhi(raw.y);
      qf[d0][4] = bflo(raw.z); qf[d0][5] = bfhi(raw.z); qf[d0][6] = bflo(raw.w); qf[d0][7] = bfhi(raw.w);
#pragma unroll
      for (int e = 0; e < 8; ++e) ss += qf[d0][e] * qf[d0][e]; }
    { auto rr = __builtin_amdgcn_permlane32_swap(__float_as_uint(ss), __float_as_uint(ss), false, false); ss = __uint_as_float(rr[0]) + __uint_as_float(rr[1]); }
    const float rs = rsqrtf(ss * (1.f / 128.f) + EPS) * (SCALE * 1.4426950408889634f);
#pragma unroll
    for (int d0 = 0; d0 < 8; ++d0) { const f32x4 g0 = *(const f32x4*)(qg + d0 * 16 + hi * 8), g1 = *(const f32x4*)(qg + d0 * 16 + hi * 8 + 4);
#pragma unroll
      for (int e = 0; e < 4; ++e) { qf[d0][e] *= rs * g0[e]; qf[d0][4 + e] *= rs * g1[e]; } }
    const int t = t0 + wid * QBLK + r32;
#pragma unroll
    for (int a = 0; a < 2; ++a) { const int pos = a ? (t & 63) : (t >> 6);
#pragma unroll
      for (int dd = 0; dd < 2; ++dd) { const float* cp = ROPE + pos * 32 + dd * 16 + hi * 8; const float* sp = cp + 2048;
        const f32x4 c0 = *(const f32x4*)cp, c1 = *(const f32x4*)(cp + 4), s0 = *(const f32x4*)sp, s1 = *(const f32x4*)(sp + 4);
#pragma unroll
        for (int e = 0; e < 8; ++e) { const float c = e < 4 ? c0[e & 3] : c1[e & 3], s = e < 4 ? s0[e & 3] : s1[e & 3];
          const float x1 = qf[4 * a + dd][e], x2 = qf[4 * a + 2 + dd][e];
          qf[4 * a + dd][e] = x1 * c - x2 * s; qf[4 * a + 2 + dd][e] = x2 * c + x1 * s; } } }
#pragma unroll
    for (int d0 = 0; d0 < 8; ++d0) { u32x4 w = {cvt_pk_bf16(qf[d0][0], qf[d0][1]), cvt_pk_bf16(qf[d0][2], qf[d0][3]), cvt_pk_bf16(qf[d0][4], qf[d0][5]), cvt_pk_bf16(qf[d0][6], qf[d0][7])};
      qr[d0] = *reinterpret_cast<bf16x8*>(&w); }
  }
  const int vst0 = v_st(sr, sc), vst1 = v_st(32 + sr, sc);
  const int vb0 = (int)(uintptr_t)V_lds + v_rd_base(lane);
#define LD8(p) (*reinterpret_cast<const bf16x8*>(p))
#define SLOAD0(k0) do { s0v0 = LD8(&Vh[(long)((k0) + sr) * LDK + sc]); s0v1 = LD8(&Vh[(long)((k0) + 32 + sr) * LDK + sc]); \
    s0k0 = LD8(&Kh[(long)((k0) + sr) * LDK + sc]); s0k1 = LD8(&Kh[(long)((k0) + 32 + sr) * LDK + sc]); } while (0)
#define SLOAD1(k0) do { s1v0 = LD8(&Vh[(long)((k0) + sr) * LDK + sc]); s1v1 = LD8(&Vh[(long)((k0) + 32 + sr) * LDK + sc]); \
    s1k0 = LD8(&Kh[(long)((k0) + sr) * LDK + sc]); s1k1 = LD8(&Kh[(long)((k0) + 32 + sr) * LDK + sc]); } while (0)
#define SWRITE0(b) do { *(bf16x8*)((char*)V_lds + (b) * SHM_V + vst0) = s0v0; *(bf16x8*)((char*)V_lds + (b) * SHM_V + vst1) = s0v1; const int kc = sc * 2; \
    *(bf16x8*)((char*)K_lds + (b) * SHM_K + KSWZ(sr, kc)) = s0k0; *(bf16x8*)((char*)K_lds + (b) * SHM_K + KSWZ(32 + sr, kc)) = s0k1; } while (0)
#define SWRITE1(b) do { *(bf16x8*)((char*)V_lds + (b) * SHM_V + vst0) = s1v0; *(bf16x8*)((char*)V_lds + (b) * SHM_V + vst1) = s1v1; const int kc = sc * 2; \
    *(bf16x8*)((char*)K_lds + (b) * SHM_K + KSWZ(sr, kc)) = s1k0; *(bf16x8*)((char*)K_lds + (b) * SHM_K + KSWZ(32 + sr, kc)) = s1k1; } while (0)
#define SWAIT() asm volatile("s_waitcnt vmcnt(4)" ::: "memory")
#define RESC(a) do { if (__any((a) < 1.f)) { if (hi == 0) al_l[r32] = (a); asm volatile("s_waitcnt lgkmcnt(0)" ::: "memory"); \
    _Pragma("unroll") for (int d = 0; d < 4; ++d) _Pragma("unroll") for (int r = 0; r < 16; ++r) o[d][r] *= al_l[crow(r, hi)]; } } while (0)
  f32x16 pA0, pA1, pB0, pB1; bf16x8 pa0, pa1, pa2, pa3; const int NT = seq / KVBLK;
  asm volatile("s_waitcnt vmcnt(0)" ::: "memory"); SWRITE0(0); __syncthreads();
  qkt(pA0, pA1, K_lds, qr, r32, hi); partialSM(pA0);
  SLOAD1(KVBLK); SLOAD0(2 * KVBLK);
  SWAIT(); SWRITE1(1); __syncthreads();
  for (int j = 1; j + 1 < NT; j += 2) {
    SBAR(); qkt(pB0, pB1, (bf16_t*)((char*)K_lds + SHM_K), qr, r32, hi);
    finishSM(pA0, pA1, l_reg, pa0, pa1, pa2, pa3); SBAR();
    SLOAD1((j + 2) * KVBLK); SBAR();
    pv_d0(o, vb0, pa0, pa1, pa2, pa3); partialSM(pB0);
    __syncthreads(); SWAIT(); SWRITE0(0);
    SBAR(); __syncthreads();
    SBAR(); qkt(pA0, pA1, K_lds, qr, r32, hi);
    finishSM(pB0, pB1, l_reg, pa0, pa1, pa2, pa3); SBAR();
    if (j + 3 < NT) SLOAD0((j + 3) * KVBLK); SBAR();
    pv_d0(o, vb0 + (int)SHM_V, pa0, pa1, pa2, pa3); partialSM(pA0);
    __syncthreads(); SWAIT(); SWRITE1(1);
    SBAR(); __syncthreads();
  }
  SBAR(); qkt(pB0, pB1, (bf16_t*)((char*)K_lds + SHM_K), qr, r32, hi);
  finishSM(pA0, pA1, l_reg, pa0, pa1, pa2, pa3); SBAR();
  pv_d0(o, vb0, pa0, pa1, pa2, pa3); partialSM(pB0);
  __syncthreads();
  finishSM(pB0, pB1, l_reg, pa0, pa1, pa2, pa3); SBAR();
  pv_d0(o, vb0 + (int)SHM_V, pa0, pa1, pa2, pa3);
  {
    const int tid2 = get_tid(wave_s), lane2 = tid2 & 63, r32b = lane2 & 31, hib = lane2 >> 5;
    float* li2 = (float*)(lds + 2 * SHM_V + 2 * SHM_K) + wave_s * 64;
    if (hib == 0) li2[r32b] = l_reg; asm volatile("s_waitcnt lgkmcnt(0)" ::: "memory");
    float rli[16];
#pragma unroll
    for (int r = 0; r < 16; ++r) rli[r] = __builtin_amdgcn_rcpf(li2[crow(r, hib)]);
    bf16_t* Ow = Ob + (long)(wave_s * QBLK) * LDO;
#pragma unroll
    for (int r = 0; r < 16; ++r) { const int orow = crow(r, hib);
#pragma unroll
      for (int d0 = 0; d0 < 4; ++d0) Ow[(long)orow * LDO + d0 * 32 + r32b] = (bf16_t)(cvt_pk_bf16(o[d0][r] * rli[r], 0.f) & 0xffffu); }
  }
  __syncthreads();
#undef LD8
#undef SLOAD0
#undef SLOAD1
#undef SWRITE0
#undef SWRITE1
#undef SWAIT
#undef RESC
}
}

struct Args { const float* in[29]; float* out; unsigned char* ws; int ph_lo, ph_hi; };
typedef const __attribute__((address_space(4))) Args* KA;
enum { I_X = 0, I_C, I_CTX, I_CCTX, I_WMOD, I_BMOD, I_NPRE, I_NPOST, I_FWI, I_FWO, I_ABWI, I_ABWO, I_SGUG, I_SGUW, I_SGUB, I_LRE, I_LIM, I_LSTEP,
       I_BRE, I_BIM, I_CRE, I_CIM, I_S5D, I_GLUW, I_GLUB, I_WQKV, I_WAO, I_QN, I_KN };

struct Ctx { LAS unsigned char* lds; int tid, lane, wave, vcu, G; };

__device__ __forceinline__ void transpose_item(const float* W, int K, int N, bf16_t* WT, int kind, LAS float* scr, int item, int lane) {
    const int nblk = N / 32, kb = item / nblk, nb = item % nblk, k0 = 64 * kb, n0 = 32 * nb;
#pragma unroll
    for (int i = 0; i < 8; ++i) { const int kk = 8 * i + (lane >> 3), cc = (lane & 7) * 4; const f32x4 w4 = *(const f32x4*)(W + (size_t)(k0 + kk) * N + n0 + cc);
        scr[kk * 33 + cc] = w4.x; scr[kk * 33 + cc + 1] = w4.y; scr[kk * 33 + cc + 2] = w4.z; scr[kk * 33 + cc + 3] = w4.w; }
    LDS_WAIT(); asm volatile("" ::: "memory");
    int r0 = n0;
    if (kind == 1) { const int up = n0 >= DFF ? 1 : 0, h = n0 - up * DFF; r0 = (h >> 7) * 256 + up * 128 + (h & 127); }
    const int c = lane & 7;
#pragma unroll
    for (int j = 0; j < 4; ++j) { const int n = (lane >> 3) + 8 * j; const LAS float* s = scr + (8 * c) * 33 + n;
        u32x4 o; o.x = cvt_pk_bf16(s[0 * 33], s[1 * 33]); o.y = cvt_pk_bf16(s[2 * 33], s[3 * 33]); o.z = cvt_pk_bf16(s[4 * 33], s[5 * 33]); o.w = cvt_pk_bf16(s[6 * 33], s[7 * 33]);
        *(u32x4*)(WT + (size_t)(r0 + n) * K + k0 + 8 * c) = o; }
    LDS_WAIT(); asm volatile("" ::: "memory");
}

__device__ __forceinline__ void s5_matrices(const Ctx& F, KA a, int g) {
    LAS float* LP = (LAS float*)F.lds;
    LAS float* BB = LP + 2 * 17 * 64 * 2;
    LAS float* CC = BB + 2 * 64 * 16 * 2;
    LAS float* KT = CC + 2 * 16 * 64 * 2;
    const float* lre = a->in[I_LRE]; const float* lim = a->in[I_LIM]; const float* lst = a->in[I_LSTEP];
    const float* bre = a->in[I_BRE]; const float* bim = a->in[I_BIM]; const float* cre = a->in[I_CRE]; const float* cim = a->in[I_CIM]; const float* dsk = a->in[I_S5D];
    if (F.tid < 128) {
        const int dir = F.tid >> 6, p = F.tid & 63; const int gi = (dir * 16 + g);
        const float lr = lre[gi * 64 + p], li = lim[gi * 64 + p], dt = expf(lst[gi]);
        const float mag = expf(lr * dt); float sn, cs; sincosf(li * dt, &sn, &cs);
        const float br = mag * cs, bi = mag * sn;
        float pr = 1.f, pi = 0.f;
        for (int tau = 0; tau <= 16; ++tau) { LP[((dir * 17 + tau) * 64 + p) * 2] = pr; LP[((dir * 17 + tau) * 64 + p) * 2 + 1] = pi;
            const float nr = pr * br - pi * bi, ni = pr * bi + pi * br; pr = nr; pi = ni; }
        const float ar = br - 1.f, ai = bi, den = lr * lr + li * li; const float zr = (ar * lr + ai * li) / den, zi = (ai * lr - ar * li) / den;
        for (int c = 0; c < 16; ++c) { const float xr = bre[(gi * 64 + p) * 16 + c], xi = bim[(gi * 64 + p) * 16 + c];
            BB[((dir * 64 + p) * 16 + c) * 2] = zr * xr - zi * xi; BB[((dir * 64 + p) * 16 + c) * 2 + 1] = zr * xi + zi * xr; }
        for (int c = 0; c < 16; ++c) { CC[((dir * 16 + c) * 64 + p) * 2] = cre[(gi * 16 + c) * 64 + p]; CC[((dir * 16 + c) * 64 + p) * 2 + 1] = cim[(gi * 16 + c) * 64 + p]; }
    }
    __syncthreads();
    for (int e = F.tid; e < 2 * 16 * 256; e += 512) {
        const int dir = e >> 12, tau = (e >> 8) & 15, c = (e >> 4) & 15, c2 = e & 15; float s = 0.f;
        for (int p = 0; p < 64; ++p) { const float cr = CC[((dir * 16 + c) * 64 + p) * 2], ci = CC[((dir * 16 + c) * 64 + p) * 2 + 1];
            const float lr = LP[((dir * 17 + tau) * 64 + p) * 2], li = LP[((dir * 17 + tau) * 64 + p) * 2 + 1];
            const float xr = BB[((dir * 64 + p) * 16 + c2) * 2], xi = BB[((dir * 64 + p) * 16 + c2) * 2 + 1];
            const float mr = cr * lr - ci * li, mi = cr * li + ci * lr; s += mr * xr - mi * xi; }
        KT[e] = s;
    }
    __syncthreads();
    bf16_t* B1 = (bf16_t*)(a->ws + WS_B1) + (size_t)g * 256 * 256; bf16_t* B2 = (bf16_t*)(a->ws + WS_B2) + (size_t)g * 256 * 512;
    for (int e = F.tid; e < 256 * 128; e += 512) {
        const int n = e >> 7, k = (e & 127) * 2, dir = n >> 7, p = (n & 127) >> 1, ri = n & 1, s = k >> 4, c2 = k & 15, pw = dir ? s : 15 - s;
        const float lr = LP[((dir * 17 + pw) * 64 + p) * 2], li = LP[((dir * 17 + pw) * 64 + p) * 2 + 1]; float v[2];
#pragma unroll
        for (int q = 0; q < 2; ++q) { const float xr = BB[((dir * 64 + p) * 16 + c2 + q) * 2], xi = BB[((dir * 64 + p) * 16 + c2 + q) * 2 + 1];
            v[q] = ri ? (lr * xi + li * xr) : (lr * xr - li * xi); }
        *(unsigned*)(B1 + (size_t)n * 256 + k) = cvt_pk_bf16(v[0], v[1]);
    }
    for (int e = F.tid; e < 256 * 256; e += 512) {
        const int n = e >> 8, k = (e & 255) * 2, t = n >> 4, c = n & 15; float v[2];
        if (k < 256) { const int s = k >> 4, c2 = k & 15;
#pragma unroll
            for (int q = 0; q < 2; ++q) { float x = 0.f; if (s <= t) x += KT[((0 * 16 + (t - s)) * 16 + c) * 16 + c2 + q]; if (s >= t) x += KT[((1 * 16 + (s - t)) * 16 + c) * 16 + c2 + q];
                if (s == t && c == c2 + q) x += dsk[g * 16 + c]; v[q] = x; }
        } else { const int kk = k - 256, dir = kk >> 7, p = (kk & 127) >> 1, pw = dir ? 16 - t : t + 1;
            const float lr = LP[((dir * 17 + pw) * 64 + p) * 2], li = LP[((dir * 17 + pw) * 64 + p) * 2 + 1];
            const float cr = CC[((dir * 16 + c) * 64 + p) * 2], ci = CC[((dir * 16 + c) * 64 + p) * 2 + 1];
            v[0] = cr * lr - ci * li; v[1] = -(cr * li + ci * lr); }
        *(unsigned*)(B2 + (size_t)n * 512 + k) = cvt_pk_bf16(v[0], v[1]);
    }
    __syncthreads();
}

__device__ __forceinline__ void mod_gemv(const Ctx& F, KA a) {
    LAS float* sl = (LAS float*)F.lds;
    LAS float* part = sl + 9 * 1024;
    for (int e = F.tid; e < 9 * 1024; e += 512) { const float v = e < 8192 ? a->in[I_C][e] : a->in[I_CCTX][e - 8192]; sl[e] = silu_f(v); }
    __syncthreads();
    float* MOD = (float*)(a->ws + WS_MOD);
    const int skip = F.G >= 64 ? 16 : 0;
    for (int task = (int)blockIdx.x - skip; task >= 0 && task < 288; task += F.G - skip) {
        const int i = task / 144, nb = task % 144;
        const float* w = a->in[I_WMOD] + (size_t)i * DM * NMODV + nb * 64 + F.lane;
        float acc[9];
#pragma unroll
        for (int r = 0; r < 9; ++r) acc[r] = 0.f;
        for (int kk = 0; kk < 128; kk += 16) { float wv[16];
#pragma unroll
            for (int u = 0; u < 16; ++u) wv[u] = w[(size_t)(F.wave * 128 + kk + u) * NMODV];
#pragma unroll
            for (int u = 0; u < 16; ++u)
#pragma unroll
                for (int r = 0; r < 9; ++r) acc[r] += sl[r * 1024 + F.wave * 128 + kk + u] * wv[u]; }
#pragma unroll
        for (int r = 0; r < 9; ++r) part[(F.wave * 9 + r) * 64 + F.lane] = acc[r];
        __syncthreads();
        for (int e = F.tid; e < 576; e += 512) { const int r = e >> 6, l = e & 63; float s = a->in[I_BMOD][i * NMODV + nb * 64 + l];
#pragma unroll
            for (int w8 = 0; w8 < 8; ++w8) s += part[(w8 * 9 + r) * 64 + l];
            MOD[(size_t)(i * 9 + r) * NMODV + nb * 64 + l] = s; }
        __syncthreads();
    }
}

__device__ __forceinline__ void p0_prologue(const Ctx& F, KA a) {
    if ((int)blockIdx.x < 16) s5_matrices(F, a, (int)blockIdx.x);
    if ((int)blockIdx.x == 16 % F.G) {
        float* RT = (float*)(a->ws + WS_ROPE);
        for (int e = F.tid; e < 2048; e += 512) { const int pos = e >> 5, f = e & 31; const float inv = powf(10000.f, -(float)(2 * f) / 64.f); const float ang = (float)pos * inv;
            float sn, cs; sincosf(ang, &sn, &cs); RT[e] = cs; RT[2048 + e] = sn; }
    }
    mod_gemv(F, a);
    LAS float* scr = (LAS float*)(F.lds + F.wave * 16384);
    const int skip = F.G >= 64 ? 16 : 0;
    const int gw = ((int)blockIdx.x - skip) * 8 + F.wave, NGW = (F.G - skip) * 8;
    constexpr int I_FI = (DM / 64) * (2 * DFF / 32), I_FO = (DFF / 64) * (DM / 32), I_ABI = (DM / 64) * (NAB / 32), I_SQ = (DM / 64) * (DM / 32), I_QKV = (DM / 64) * (NQKV / 32), I_GLU = (DB / 64) * (DB / 32);
    constexpr int NITEMS = 4 * I_FI + 4 * I_FO + I_ABI + I_SQ + I_QKV + I_SQ + I_GLU;
    for (int it = gw; it >= 0 && it < NITEMS; it += NGW) {
        int r = it;
        if (r < 4 * I_FI) { const int q = r / I_FI; transpose_item(a->in[I_FWI] + (size_t)q * DM * 2 * DFF, DM, 2 * DFF, (bf16_t*)(a->ws + WS_WFI + q * SZ_WFI), 1, scr, r % I_FI, F.lane); continue; } r -= 4 * I_FI;
        if (r < 4 * I_FO) { const int q = r / I_FO; transpose_item(a->in[I_FWO] + (size_t)q * DFF * DM, DFF, DM, (bf16_t*)(a->ws + WS_WFO + q * SZ_WFO), 0, scr, r % I_FO, F.lane); continue; } r -= 4 * I_FO;
        if (r < I_ABI) { transpose_item(a->in[I_ABWI], DM, NAB, (bf16_t*)(a->ws + WS_WABI), 0, scr, r, F.lane); continue; } r -= I_ABI;
        if (r < I_SQ) { transpose_item(a->in[I_ABWO], DM, DM, (bf16_t*)(a->ws + WS_WABO), 0, scr, r, F.lane); continue; } r -= I_SQ;
        if (r < I_QKV) { transpose_item(a->in[I_WQKV], DM, NQKV, (bf16_t*)(a->ws + WS_WQKV), 0, scr, r, F.lane); continue; } r -= I_QKV;
        if (r < I_SQ) { transpose_item(a->in[I_WAO], DM, DM, (bf16_t*)(a->ws + WS_WAO), 0, scr, r, F.lane); continue; } r -= I_SQ;
        transpose_item(a->in[I_GLUW], DB, DB, (bf16_t*)(a->ws + WS_WGLU), 0, scr, r, F.lane);
    }
    { const float* src = a->in[I_SGUW]; bf16_t* dst = (bf16_t*)(a->ws + WS_WSGU);
      for (int e = (blockIdx.x * 512 + F.tid) * 2; e < 6 * 128 * 128; e += F.G * 512 * 2) *(unsigned*)(dst + e) = cvt_pk_bf16(src[e], src[e + 1]); }
}

struct Ew { const float* xl; const float* xc; const _Float16* xh; _Float16* oh; float* of; const bf16_t* Y; const float* gpost; const float* gate; float w;
            const float* gpre; const float* shift; const float* scale; bf16_t* H; int latent_only; };
__device__ __forceinline__ void ew_pass(const Ctx& F, const Ew& e) {
    constexpr int NR = 4;
    typedef _Float16 f16x8 __attribute__((ext_vector_type(8))); typedef float f32x8 __attribute__((ext_vector_type(8)));
    const int gw = F.vcu * 8 + F.wave, NGW = F.G * 8;
    const bool hasY = e.Y != nullptr, f32src = e.xl != nullptr, hasH = e.H != nullptr;
    LAS f32x4* PA = (LAS f32x4*)F.lds; LAS f32x4* PB = PA + 9 * 256; LAS f32x4* PC = PB + 9 * 256;
    { const float* p_gpost = e.gpost; const float* p_gate = e.gate; const float* p_gpre = e.gpre; const float* p_scale = e.scale; const float* p_shift = e.shift; float wgt = e.w;
      asm volatile("" : "+s"(p_gpost), "+s"(p_gate), "+s"(p_gpre), "+s"(p_scale), "+s"(p_shift), "+s"(wgt));
      for (int idx = F.tid; idx < 9 * 256; idx += 512) { const int r = idx >> 8, c = (idx >> 6) & 3, l = idx & 63, c4 = (c >> 1) * 128 + l * 2 + (c & 1);
        if (hasY) PA[idx] = ((const f32x4*)p_gpost)[c4] * ((const f32x4*)(p_gate + (size_t)r * NMODV))[c4] * wgt;
        if (hasH) { PB[idx] = ((const f32x4*)p_gpre)[c4] * (((const f32x4*)(p_scale + (size_t)r * NMODV))[c4] + 1.f); PC[idx] = ((const f32x4*)(p_shift + (size_t)r * NMODV))[c4]; } } }
    __syncthreads();
    for (int R0 = gw; R0 < MR; R0 += NR * NGW) {
        f32x4 v[NR][4]; u32x4 yw[NR][2]; bool act[NR]; size_t xoff[NR]; int mrow[NR]; bool isc[NR];
#pragma unroll
        for (int k = 0; k < NR; ++k) {
            const int R = R0 + k * NGW; const int Rc = R < MR ? R : 0; const int b = Rc / RPB, j = Rc - b * RPB; isc[k] = j < CTXL;
            act[k] = (R < MR) && !(isc[k] && e.latent_only);
            xoff[k] = isc[k] ? (size_t)(b * CTXL + j) * DM : (size_t)(b * SEQ + j - CTXL) * DM; mrow[k] = isc[k] ? 8 : b;
            if (act[k]) {
                if (f32src) { const f32x4* xr = (const f32x4*)((isc[k] ? e.xc : e.xl) + xoff[k]) + F.lane * 2;
#pragma unroll
                    for (int c = 0; c < 4; ++c) v[k][c] = __builtin_nontemporal_load(xr + (c >> 1) * 128 + (c & 1)); }
                else { const f16x8* xr = (const f16x8*)(e.xh + (size_t)Rc * DM) + F.lane;
#pragma unroll
                    for (int q = 0; q < 2; ++q) { const f32x8 t = __builtin_convertvector(__builtin_nontemporal_load(xr + 64 * q), f32x8);
                        v[k][2 * q] = (f32x4){t[0], t[1], t[2], t[3]}; v[k][2 * q + 1] = (f32x4){t[4], t[5], t[6], t[7]}; } }
                if (hasY) { const u32x4* yr = (const u32x4*)(e.Y + (size_t)Rc * DM) + F.lane;
#pragma unroll
                    for (int q = 0; q < 2; ++q) yw[k][q] = __builtin_nontemporal_load(yr + 64 * q); }
            }
        }
#pragma unroll
        for (int k = 0; k < NR; ++k) {
            if (!act[k]) continue;
            const int R = R0 + k * NGW;
            if (hasY) {
                f32x4 y[4]; float ss = 0.f;
#pragma unroll
                for (int q = 0; q < 2; ++q) { const u32x4 w = yw[k][q]; y[2 * q] = (f32x4){bflo(w.x), bfhi(w.x), bflo(w.y), bfhi(w.y)}; y[2 * q + 1] = (f32x4){bflo(w.z), bfhi(w.z), bflo(w.w), bfhi(w.w)}; }
#pragma unroll
                for (int c = 0; c < 4; ++c) ss += (y[c].x * y[c].x + y[c].y * y[c].y) + (y[c].z * y[c].z + y[c].w * y[c].w);
                const float rs = rsqrtf(wave_sum(ss) * (1.f / DM) + EPS);
                const LAS f32x4* pa = PA + mrow[k] * 256 + F.lane;
#pragma unroll
                for (int c = 0; c < 4; ++c) v[k][c] += (y[c] * rs) * pa[64 * c];
            }
            if (e.oh) { f16x8* o = (f16x8*)(e.oh + (size_t)R * DM) + F.lane;
#pragma unroll
                for (int q = 0; q < 2; ++q) { const f32x4 a0 = v[k][2 * q], a1 = v[k][2 * q + 1]; const f32x8 t = {a0.x, a0.y, a0.z, a0.w, a1.x, a1.y, a1.z, a1.w};
                    __builtin_nontemporal_store(__builtin_convertvector(t, f16x8), o + 64 * q); } }
            if (e.of) { f32x4* o = (f32x4*)(e.of + xoff[k]) + F.lane * 2;
#pragma unroll
                for (int c = 0; c < 4; ++c) __builtin_nontemporal_store(v[k][c], o + (c >> 1) * 128 + (c & 1)); }
            if (hasH) {
                float ss = 0.f;
#pragma unroll
                for (int c = 0; c < 4; ++c) ss += (v[k][c].x * v[k][c].x + v[k][c].y * v[k][c].y) + (v[k][c].z * v[k][c].z + v[k][c].w * v[k][c].w);
                const float rs = rsqrtf(wave_sum(ss) * (1.f / DM) + EPS);
                const LAS f32x4* pb = PB + mrow[k] * 256 + F.lane; const LAS f32x4* pc = PC + mrow[k] * 256 + F.lane;
                u32x4* h = (u32x4*)(e.H + (size_t)R * DM) + F.lane;
#pragma unroll
                for (int q = 0; q < 2; ++q) { const f32x4 t0 = (v[k][2 * q] * rs) * pb[64 * (2 * q)] + pc[64 * (2 * q)], t1 = (v[k][2 * q + 1] * rs) * pb[64 * (2 * q + 1)] + pc[64 * (2 * q + 1)];
                    u32x4 w; w.x = cvt_pk_bf16(t0.x, t0.y); w.y = cvt_pk_bf16(t0.z, t0.w); w.z = cvt_pk_bf16(t1.x, t1.y); w.w = cvt_pk_bf16(t1.z, t1.w); h[64 * q] = w; }
            }
        }
    }
}

__device__ __forceinline__ void sgu_phase(const Ctx& F, KA a, int first, int stride) {
    constexpr int LDO = 136;
    const bf16_t* P = (const bf16_t*)(a->ws + WS_BIG); bf16_t* MIX = (bf16_t*)(a->ws + WS_H); const bf16_t* W = (const bf16_t*)(a->ws + WS_WSGU);
    const float* gam = a->in[I_SGUG]; const float* sb = a->in[I_SGUB];
    const int l16 = F.tid & 15, srow = F.tid >> 4, hi = F.lane >> 5, r32 = F.lane & 31, tq = F.wave >> 1, chh = F.wave & 1;
    const int vb = (int)(uintptr_t)(unsigned char*)F.lds + att::v_rd_base(F.lane);
    LAS bf16_t* OUT = (LAS bf16_t*)(F.lds + 32768);
    constexpr int NU = (MR / 128) * 6;
    u32x4 rv[4], ru[4];
    if (first < NU) { const int n = first / 6, g = first - n * 6;
#pragma unroll
        for (int pass = 0; pass < 4; ++pass) { const bf16_t* p = P + (size_t)(n * 128 + pass * 32 + srow) * 1536 + g * 128 + l16 * 8; rv[pass] = *(const u32x4*)(p + DA); ru[pass] = *(const u32x4*)p; } }
    for (int unit = first; unit < NU; unit += stride) {
        const int n = unit / 6, g = unit - n * 6;
        u32x4 gu[4];
        const f32x4 g0 = *(const f32x4*)(gam + g * 128 + l16 * 8), g1 = *(const f32x4*)(gam + g * 128 + l16 * 8 + 4);
#pragma unroll
        for (int pass = 0; pass < 4; ++pass) { const int s = pass * 32 + srow; const u32x4 raw = rv[pass];
            float v[8] = {bflo(raw.x), bfhi(raw.x), bflo(raw.y), bfhi(raw.y), bflo(raw.z), bfhi(raw.z), bflo(raw.w), bfhi(raw.w)}; float sm = 0.f;
#pragma unroll
            for (int q = 0; q < 8; ++q) { v[q] = gelu_tanh(v[q]); sm += v[q]; }
            sm += __shfl_xor(sm, 1); sm += __shfl_xor(sm, 2); sm += __shfl_xor(sm, 4); sm += __shfl_xor(sm, 8);
            const float mu = sm * (1.f / 128.f); float vq = 0.f;
#pragma unroll
            for (int q = 0; q < 8; ++q) { v[q] -= mu; vq += v[q] * v[q]; }
            vq += __shfl_xor(vq, 1); vq += __shfl_xor(vq, 2); vq += __shfl_xor(vq, 4); vq += __shfl_xor(vq, 8);
            const float rs = rsqrtf(vq * (1.f / 128.f) + EPS);
            u32x4 w; w.x = cvt_pk_bf16(v[0] * rs * g0[0], v[1] * rs * g0[1]); w.y = cvt_pk_bf16(v[2] * rs * g0[2], v[3] * rs * g0[3]);
            w.z = cvt_pk_bf16(v[4] * rs * g1[0], v[5] * rs * g1[1]); w.w = cvt_pk_bf16(v[6] * rs * g1[2], v[7] * rs * g1[3]);
            *(LAS u32x4*)(F.lds + (s >> 6) * 16384 + att::v_st(s & 63, l16 * 8)) = w;
            const u32x4 u = ru[pass];
            gu[pass].x = cvt_pk_bf16(gelu_tanh(bflo(u.x)), gelu_tanh(bfhi(u.x))); gu[pass].y = cvt_pk_bf16(gelu_tanh(bflo(u.y)), gelu_tanh(bfhi(u.y)));
            gu[pass].z = cvt_pk_bf16(gelu_tanh(bflo(u.z)), gelu_tanh(bfhi(u.z))); gu[pass].w = cvt_pk_bf16(gelu_tanh(bflo(u.w)), gelu_tanh(bfhi(u.w)));
        }
        { const int nu = unit + stride;
          if (nu < NU) { const int n2 = nu / 6, g2 = nu - n2 * 6;
#pragma unroll
            for (int pass = 0; pass < 4; ++pass) { const bf16_t* p = P + (size_t)(n2 * 128 + pass * 32 + srow) * 1536 + g2 * 128 + l16 * 8; rv[pass] = *(const u32x4*)(p + DA); ru[pass] = *(const u32x4*)p; } } }
        const bf16_t* Wg = W + (size_t)g * 128 * 128 + (size_t)(tq * 32 + r32) * 128 + hi * 8;
        bf16x8 wf[2][4];
#pragma unroll
        for (int tile = 0; tile < 2; ++tile)
#pragma unroll
            for (int ks = 0; ks < 4; ++ks) wf[tile][ks] = *(const bf16x8*)(Wg + tile * 64 + ks * 16);
        float bs[16];
#pragma unroll
        for (int r = 0; r < 16; ++r) bs[r] = sb[g * 128 + tq * 32 + att::crow(r, hi)];
        __syncthreads();
        f32x16 acc0 = {}, acc1 = {};
#pragma unroll
        for (int tile = 0; tile < 2; ++tile) {
            if (chh == 0) { att::pv_one<0>(acc0, vb + tile * 16384, wf[tile][0], wf[tile][1], wf[tile][2], wf[tile][3]); att::pv_one<1>(acc1, vb + tile * 16384, wf[tile][0], wf[tile][1], wf[tile][2], wf[tile][3]); }
            else { att::pv_one<2>(acc0, vb + tile * 16384, wf[tile][0], wf[tile][1], wf[tile][2], wf[tile][3]); att::pv_one<3>(acc1, vb + tile * 16384, wf[tile][0], wf[tile][1], wf[tile][2], wf[tile][3]); }
        }
#pragma unroll
        for (int r = 0; r < 16; ++r) { const int t = tq * 32 + att::crow(r, hi); const float bias = bs[r];
            OUT[t * LDO + chh * 64 + r32] = (bf16_t)(cvt_pk_bf16(acc0[r] + bias, 0.f) & 0xffffu); OUT[t * LDO + chh * 64 + 32 + r32] = (bf16_t)(cvt_pk_bf16(acc1[r] + bias, 0.f) & 0xffffu); }
        __syncthreads();
#pragma unroll
        for (int pass = 0; pass < 4; ++pass) { const int t = pass * 32 + srow; const u32x4 m = *(const LAS u32x4*)(OUT + t * LDO + l16 * 8); const u32x4 u = gu[pass]; u32x4 w;
            w.x = cvt_pk_bf16(bflo(u.x) * bflo(m.x), bfhi(u.x) * bfhi(m.x)); w.y = cvt_pk_bf16(bflo(u.y) * bflo(m.y), bfhi(u.y) * bfhi(m.y));
            w.z = cvt_pk_bf16(bflo(u.z) * bflo(m.z), bfhi(u.z) * bfhi(m.z)); w.w = cvt_pk_bf16(bflo(u.w) * bflo(m.w), bfhi(u.w) * bfhi(m.w));
            *(u32x4*)(MIX + (size_t)(n * 128 + t) * DM + g * 128 + l16 * 8) = w; }
    }
    __syncthreads();
}

__device__ __forceinline__ void s5_scan(const Ctx& F, KA a) {
    constexpr int SEG = CPB / 8;
    const float* S = (const float*)(a->ws + WS_S); bf16_t* A2 = (bf16_t*)(a->ws + WS_A2);
    LAS float* seg = (LAS float*)(F.lds + 69632);
    for (int task = F.vcu; task < NB * 16 * 2; task += F.G) {
        const int dir = task & 1, g = (task >> 1) & 15, b = task >> 5, p = F.lane, w = F.wave; const int gi = dir * 16 + g;
        const float lr = a->in[I_LRE][gi * 64 + p], li = a->in[I_LIM][gi * 64 + p], dt = expf(a->in[I_LSTEP][gi]);
        const float mag = expf(lr * dt); float sn, cs; sincosf(li * dt, &sn, &cs);
        float ar = mag * cs, ai = mag * sn;
#pragma unroll
        for (int q = 0; q < 4; ++q) { const float nr = ar * ar - ai * ai, ni = 2.f * ar * ai; ar = nr; ai = ni; }
        f32x2 sv[SEG];
#pragma unroll
        for (int u = 0; u < SEG; ++u) { const int k = w * SEG + u, nat = dir ? (k < 16 ? 15 - k : 287 - k) : k;
            sv[u] = *(const f32x2*)(S + ((size_t)(g * NCHP + b * CPB + nat) * 256 + dir * 128 + 2 * p)); }
        float hr = 0.f, hi_ = 0.f, qr = 1.f, qi = 0.f;
#pragma unroll
        for (int u = 0; u < SEG; ++u) { const float nr = ar * hr - ai * hi_ + sv[u].x, ni = ar * hi_ + ai * hr + sv[u].y; hr = nr; hi_ = ni;
            const float tr = qr * ar - qi * ai, ti = qr * ai + qi * ar; qr = tr; qi = ti; }
        seg[(w * 64 + p) * 2] = hr; seg[(w * 64 + p) * 2 + 1] = hi_;
        __syncthreads();
        float cr = 0.f, ci = 0.f;
        for (int v = 0; v < w; ++v) { const float fr_ = seg[(v * 64 + p) * 2], fi_ = seg[(v * 64 + p) * 2 + 1]; const float nr = qr * cr - qi * ci + fr_, ni = qr * ci + qi * cr + fi_; cr = nr; ci = ni; }
        hr = cr; hi_ = ci;
#pragma unroll
        for (int u = 0; u < SEG; ++u) { const int k = w * SEG + u, nat = dir ? (k < 16 ? 15 - k : 287 - k) : k;
            *(unsigned*)(A2 + ((size_t)(g * NCHP + b * CPB + nat) * 512 + 256 + dir * 128 + 2 * p)) = cvt_pk_bf16(hr, hi_);
            const float nr = ar * hr - ai * hi_ + sv[u].x, ni = ar * hi_ + ai * hr + sv[u].y; hr = nr; hi_ = ni; }
        __syncthreads();
    }
}

__device__ __forceinline__ void kv_prep(const Ctx& F, KA a) {
    constexpr int NR = 4;
    const int gw = F.vcu * 8 + F.wave, NGW = F.G * 8;
    const bf16_t* QKV = (const bf16_t*)(a->ws + WS_BIG); bf16_t* KB = (bf16_t*)(a->ws + WS_KB); bf16_t* VB = (bf16_t*)(a->ws + WS_VB);
    const float* RT = (const float*)(a->ws + WS_ROPE); const float* kg = a->in[I_KN];
    const int seg = F.lane >> 4, l16 = F.lane & 15;
    const f32x4 g0 = *(const f32x4*)(kg + l16 * 8), g1 = *(const f32x4*)(kg + l16 * 8 + 4);
    for (int R0 = gw; R0 < MR; R0 += NR * NGW) {
        u32x4 raws[NR];
#pragma unroll
        for (int k = 0; k < NR; ++k) { const int R = R0 + k * NGW; if (R < MR) raws[k] = *(const u32x4*)(QKV + (size_t)R * NQKV + 1024 + seg * 128 + l16 * 8); }
#pragma unroll
        for (int k = 0; k < NR; ++k) { const int R = R0 + k * NGW; if (R >= MR) continue;
            const int b = R / RPB, j = R - b * RPB; const bool lat = j >= CTXL; const int t = j - CTXL; const u32x4 raw = raws[k];
            float f[8] = {bflo(raw.x), bfhi(raw.x), bflo(raw.y), bfhi(raw.y), bflo(raw.z), bfhi(raw.z), bflo(raw.w), bfhi(raw.w)}; float ss = 0.f;
#pragma unroll
            for (int q = 0; q < 8; ++q) ss += f[q] * f[q];
            ss += __shfl_xor(ss, 1); ss += __shfl_xor(ss, 2); ss += __shfl_xor(ss, 4); ss += __shfl_xor(ss, 8);
            const float rs = rsqrtf(ss * (1.f / 128.f) + EPS);
            float pf[8];
#pragma unroll
            for (int q = 0; q < 8; ++q) { f[q] *= rs * (q < 4 ? g0[q & 3] : g1[q & 3]); pf[q] = __shfl_xor(f[q], 4); }
            if (lat) { const int ax = l16 >> 3, pos = ax ? (t & 63) : (t >> 6); const bool first = (l16 & 7) < 4; const int fb = (l16 & 3) * 8;
                const f32x4 c0 = *(const f32x4*)(RT + pos * 32 + fb), c1 = *(const f32x4*)(RT + pos * 32 + fb + 4), s0 = *(const f32x4*)(RT + 2048 + pos * 32 + fb), s1 = *(const f32x4*)(RT + 2048 + pos * 32 + fb + 4);
#pragma unroll
                for (int q = 0; q < 8; ++q) { const float c = q < 4 ? c0[q & 3] : c1[q & 3], sn = q < 4 ? s0[q & 3] : s1[q & 3]; f[q] = first ? f[q] * c - pf[q] * sn : f[q] * c + pf[q] * sn; } }
            u32x4 w; w.x = cvt_pk_bf16(f[0], f[1]); w.y = cvt_pk_bf16(f[2], f[3]); w.z = cvt_pk_bf16(f[4], f[5]); w.w = cvt_pk_bf16(f[6], f[7]);
            if (seg < 2) *(u32x4*)(KB + ((size_t)((b * 2 + seg) * RPB + j) * 128 + l16 * 8)) = w;
            else *(u32x4*)(VB + ((size_t)((b * 2 + seg - 2) * RPB + j) * 128 + l16 * 8)) = raw;
        }
    }
}

__device__ __forceinline__ void attn_phase(const Ctx& F, KA a, char* lds_generic) {
    const bf16_t* QKV = (const bf16_t*)(a->ws + WS_BIG); const bf16_t* KB = (const bf16_t*)(a->ws + WS_KB); const bf16_t* VB = (const bf16_t*)(a->ws + WS_VB);
    bf16_t* O = (bf16_t*)(a->ws + WS_H); const float* RT = (const float*)(a->ws + WS_ROPE);
    int seq_ = RPB; asm volatile("" : "+s"(seq_));
    for (int i = 0;; ++i) {
        int uidx;
        if (F.G == 256) { const int x = F.vcu >> 5, w = F.vcu & 31; if (i >= 4) break; const int pair = x * 2 + (i >> 1), sub = (i & 1) * 32 + w; uidx = pair * 64 + sub; }
        else { uidx = i * F.G + F.vcu; if (uidx >= 1024) break; }
        const int pair = uidx >> 6, sub = uidx & 63, b = pair >> 1, kvh = pair & 1, h = kvh * 4 + (sub >> 4), qb = sub & 15;
        const size_t R0 = (size_t)b * RPB + CTXL + qb * 256;
        att::attn_dense_body(QKV + R0 * NQKV + h * 128, KB + (size_t)(b * 2 + kvh) * RPB * 128, VB + (size_t)(b * 2 + kvh) * RPB * 128,
                             O + R0 * DM + h * 128, seq_, lds_generic, qb * 256, a->in[I_QN], RT, F.wave);
    }
}

constexpr int N_PHASES = 26;
enum { T_PRO = 0, T_EW = 1, T_GEMM = 2, T_SCAN = 3, T_KV = 4, T_ATTN = 5 };
__device__ __forceinline__ int phase_type(int ph) {
    if (ph == 0) return T_PRO;
    if (ph == 1 || ph == 4 || ph == 11 || ph == 14 || ph == 17 || ph == 22 || ph == 25) return T_EW;
    if (ph == 7) return T_SCAN; if (ph == 19) return T_KV; if (ph == 20) return T_ATTN;
    return T_GEMM;
}
struct GemmCfg {
    int ph; unsigned char* ws; const float* glub; int G, c, wave_s;
    __device__ __forceinline__ void opaque() { asm volatile("" : "+s"(ph)); }
    __device__ __forceinline__ void get(pg8::Gemm& g, pg8::Order& S, pg8::Epi& E) const {
        bf16_t* H = (bf16_t*)(ws + WS_H); bf16_t* BIG = (bf16_t*)(ws + WS_BIG); bf16_t* Y = (bf16_t*)(ws + WS_Y);
        g.A = H; g.Bt = nullptr; g.lda = DM; g.ldb = DM; g.K = DM; int nM = MR / 256, nN = 4, kind = 0;
        E.mode = pg8::EM_BF16; E.O = Y; E.ldc = DM; E.O2 = nullptr; E.aux = nullptr; E.bias = nullptr; E.Of = nullptr;
        if (ph == 2 || ph == 12 || ph == 15 || ph == 23) { const int q = ph == 2 ? 0 : ph == 12 ? 1 : ph == 15 ? 2 : 3; g.Bt = (const bf16_t*)(ws + WS_WFI + (size_t)q * SZ_WFI); nN = 2 * DFF / 256;
            E.mode = pg8::EM_SWIGLU; E.O = BIG; E.ldc = DFF; if (ph == 23) { nM = 128; kind = 1; } }
        else if (ph == 3 || ph == 13 || ph == 16 || ph == 24) { const int q = ph == 3 ? 0 : ph == 13 ? 1 : ph == 16 ? 2 : 3; g.A = BIG; g.lda = DFF; g.ldb = DFF; g.K = DFF; g.Bt = (const bf16_t*)(ws + WS_WFO + (size_t)q * SZ_WFO);
            if (ph == 24) { nM = 128; kind = 1; } }
        else if (ph == 5) { g.Bt = (const bf16_t*)(ws + WS_WABI); nN = NAB / 256; E.mode = pg8::EM_ABIN; E.O = BIG; E.ldc = 1536; E.O2 = (bf16_t*)(ws + WS_A2); }
        else if (ph == 6) { g.A = (const bf16_t*)(ws + WS_A2); g.lda = 512; g.Bt = (const bf16_t*)(ws + WS_B1); g.ldb = 256; g.K = 256; nM = 144; nN = 1; kind = 2; E.mode = pg8::EM_S5G1; E.Of = (float*)(ws + WS_S); }
        else if (ph == 8) { g.A = (const bf16_t*)(ws + WS_A2); g.lda = 512; g.Bt = (const bf16_t*)(ws + WS_B2); g.ldb = 512; g.K = 512; nM = 144; nN = 1; kind = 2; E.mode = pg8::EM_S5G2; E.O = (bf16_t*)(ws + WS_YB); }
        else if (ph == 9) { g.A = (const bf16_t*)(ws + WS_YB); g.lda = DB; g.Bt = (const bf16_t*)(ws + WS_WGLU); g.ldb = DB; g.K = DB; nN = 1; E.mode = pg8::EM_GLU; E.O2 = H; E.aux = (const bf16_t*)(ws + WS_YB); E.bias = glub; }
        else if (ph == 10) { g.Bt = (const bf16_t*)(ws + WS_WABO); }
        else if (ph == 18) { g.Bt = (const bf16_t*)(ws + WS_WQKV); nN = NQKV / 256; E.O = BIG; E.ldc = NQKV; }
        else { g.Bt = (const bf16_t*)(ws + WS_WAO); nM = 128; kind = 1; }
        S.init(nM, nN, G, c, kind);
    }
};
__device__ __forceinline__ void ew_cfg(int ph, KA a, Ew& e) {
    unsigned char* ws = a->ws; _Float16* XH = (_Float16*)(ws + WS_XC); const float* MOD = (const float*)(ws + WS_MOD);
    const float* npre = a->in[I_NPRE]; const float* npost = a->in[I_NPOST];
#define MODP(i, slot) (MOD + (size_t)(i) * 9 * NMODV + (slot) * DM)
    e.xl = nullptr; e.xc = nullptr; e.xh = XH; e.oh = XH; e.of = nullptr; e.Y = (const bf16_t*)(ws + WS_Y); e.gpost = nullptr; e.gate = nullptr; e.w = 0.5f; e.gpre = nullptr; e.shift = nullptr; e.scale = nullptr; e.H = (bf16_t*)(ws + WS_H); e.latent_only = 0;
    const int L = ph >= 15 ? 1 : 0;
    if (ph == 1) { e.xl = a->in[I_X]; e.xc = a->in[I_CTX]; e.oh = nullptr; e.Y = nullptr; e.gpre = npre; e.shift = MODP(0, 0); e.scale = MODP(0, 1); }
    else if (ph == 4 || ph == 17) { if (L == 0) { e.xl = a->in[I_X]; e.xc = a->in[I_CTX]; }
        e.gpost = npost + (L * 3 + 0) * DM; e.gate = MODP(L, 2); e.gpre = npre + (L * 3 + 1) * DM; e.shift = MODP(L, 3); e.scale = MODP(L, 4); }
    else if (ph == 11 || ph == 22) { e.gpost = npost + (L * 3 + 1) * DM; e.gate = MODP(L, 5); e.w = 1.0f; e.gpre = npre + (L * 3 + 2) * DM; e.shift = MODP(L, 6); e.scale = MODP(L, 7); e.latent_only = L; }
    else if (ph == 14) { e.gpost = npost + 2 * DM; e.gate = MODP(0, 8); e.gpre = npre + 3 * DM; e.shift = MODP(1, 0); e.scale = MODP(1, 1); }
    else { e.gpost = npost + 5 * DM; e.gate = MODP(1, 8); e.H = nullptr; e.oh = nullptr; e.of = a->out; e.latent_only = 1; }
#undef MODP
}
#define XB_TMO      128
#define XB_XCNT(j)  (256  + 64 * (j))
#define XB_XSUB(j)  (1280 + 64 * (j))
#define XB_XGEN(j)  (2304 + 64 * (j))
#define XB_TOP      3328
#define XB_TOPGEN   3392
#define XCD_BAR_WORDS 3456
#define XB_SPIN_CAP (1u << 20)
__device__ __forceinline__ unsigned xb_ld(unsigned* p)              { return __hip_atomic_load(p, __ATOMIC_RELAXED, __HIP_MEMORY_SCOPE_AGENT); }
__device__ __forceinline__ unsigned xb_add(unsigned* p, unsigned v) { return __hip_atomic_fetch_add(p, v, __ATOMIC_RELAXED, __HIP_MEMORY_SCOPE_AGENT); }
__device__ __forceinline__ unsigned xb_xcc_id() { return (unsigned)__builtin_amdgcn_s_getreg((3 << 11) | 20) & 0xFu; }
#define XB_SPIN(cond, bar) do { unsigned _sp = 0; while (cond) { __builtin_amdgcn_s_sleep(1); \
    if ((++_sp & 255u) == 0u) { if (xb_ld(&(bar)[XB_TMO])) break; if (_sp > XB_SPIN_CAP) { atomicAdd(&(bar)[XB_TMO], 1u); break; } } } } while (0)
__device__ __forceinline__ void xcd_barrier_complete(unsigned* bar, unsigned x, unsigned& nloc, unsigned& nx) {
    const unsigned G = gridDim.x * gridDim.y * gridDim.z;
    unsigned sum, cnt, mine, sp = 0u;
    for (;;) {
        sum = 0u; cnt = 0u; mine = 0u;
#pragma unroll
        for (unsigned j = 0; j < 16; ++j) { const unsigned c = xb_ld(&bar[XB_XCNT(j)]); sum += c; cnt += (c > 0u) ? 1u : 0u; mine = (j == x) ? c : mine; }
        if (sum == G) break;
        __builtin_amdgcn_s_sleep(1);
        if ((++sp & 255u) == 0u) { if (xb_ld(&bar[XB_TMO])) break; if (sp > XB_SPIN_CAP) { atomicAdd(&bar[XB_TMO], 1u); break; } }
    }
    nloc = mine > 0u ? mine : 1u; nx = cnt > 0u ? cnt : 1u;
}
__device__ __forceinline__ void xcd_barrier(unsigned* bar, unsigned x, volatile LAS unsigned* st, int tid) {
    asm volatile("s_waitcnt vmcnt(0)" ::: "memory");
    __syncthreads();
    if (tid == 0) {
        __builtin_amdgcn_s_waitcnt(0);
        unsigned nloc = st[0], nx = st[1];
        if (nloc == 0u) { xcd_barrier_complete(bar, x, nloc, nx); st[0] = nloc; st[1] = nx; }
        const unsigned old = xb_add(&bar[XB_XSUB(x)], 1u);
        const unsigned gen = old / nloc;
        if (old + 1u == (gen + 1u) * nloc) {
            __builtin_amdgcn_fence(__ATOMIC_RELEASE, "agent");
            asm volatile("s_waitcnt vmcnt(0)" ::: "memory");
            const unsigned og = xb_add(&bar[XB_TOP], 1u);
            const unsigned tg = og / nx;
            if (og + 1u == (tg + 1u) * nx) xb_add(&bar[XB_TOPGEN], 1u);
            else XB_SPIN(xb_ld(&bar[XB_TOPGEN]) == tg, bar);
            __builtin_amdgcn_fence(__ATOMIC_ACQUIRE, "agent");
            xb_add(&bar[XB_XGEN(x)], 1u);
            asm volatile("s_waitcnt vmcnt(0)" ::: "memory");
        } else {
            XB_SPIN(xb_ld(&bar[XB_XGEN(x)]) == gen, bar);
            __builtin_amdgcn_fence(__ATOMIC_ACQUIRE, "agent");
            asm volatile("s_waitcnt vmcnt(0)" ::: "memory");
        }
    }
    __syncthreads();
}
#ifndef PHM
#define PHM 127
#endif
#ifndef DBL_MASK
#define DBL_MASK 0u
#endif
#ifndef DBL_BAR
#define DBL_BAR 0
#endif
#define NREP(ph_) (((DBL_MASK >> (ph_)) & 1u) ? 2 : 1)
__global__ void __launch_bounds__(512, 2) mk_fwd(Args a_unused) {
    extern __shared__ __attribute__((aligned(16))) unsigned char lds[];
#if !MK_PER_PHASE
    cg::grid_group grid = cg::this_grid();
#define SEAM(ph_) do { if ((ph_) + 1 < hi) { for (int rb_ = 0; rb_ < 1 + DBL_BAR; ++rb_) { if ((ph_) == 0) grid.sync(); else xcd_barrier(xbar, xcc, (volatile LAS unsigned*)((LAS unsigned char*)lds + 131072), get_tid(wave_s)); } } } while (0)
#else
#define SEAM(ph_) do {} while (0)
#endif
    KA a0 = (KA)__builtin_amdgcn_kernarg_segment_ptr();
    const int wave_s = __builtin_amdgcn_readfirstlane((int)threadIdx.x >> 6);
    const int lo = a0->ph_lo, hi = a0->ph_hi;
    unsigned* const xbar = (unsigned*)(a0->ws + WS_BAR); const unsigned xcc = xb_xcc_id();
    if (threadIdx.x == 0) { ((volatile LAS unsigned*)((LAS unsigned char*)lds + 131072))[0] = 0u; ((volatile LAS unsigned*)((LAS unsigned char*)lds + 131072))[1] = 0u;
#if !MK_PER_PHASE
        (void)xb_add(&xbar[XB_XCNT(xcc)], 1u);
#endif
    }
    __syncthreads();
#define MKCTX() Ctx F; F.lds = (LAS unsigned char*)lds; F.tid = get_tid(wave_s); F.lane = F.tid & 63; F.wave = wave_s; \
        F.G = gridDim.x; { const int bx = blockIdx.x; F.vcu = (F.G % 8 == 0) ? (bx % 8) * (F.G / 8) + bx / 8 : bx; }
#define LIGHT_OR_GEMM(ph) do { \
        KA a = a0; asm volatile("" : "+s"(a)); \
        const int type = phase_type(ph); \
        for (int rep_ = 0; rep_ < NREP(ph); ++rep_) \
        if (type == T_EW) { if (PHM & 2) { MKCTX(); Ew e; ew_cfg(ph, a, e); ew_pass(F, e); } } \
        else if (type == T_GEMM) { \
            if (PHM & 8) { GemmCfg cfg{ph, a->ws, a->in[I_GLUB], (int)gridDim.x, (int)blockIdx.x, wave_s}; pg8::gemm_phase((LAS unsigned char*)lds, cfg); } \
        } else if (type == T_SCAN) { if (PHM & 16) { MKCTX(); s5_scan(F, a); sgu_phase(F, a, F.vcu, F.G); } } \
        else if (type == T_KV) { if (PHM & 32) { MKCTX(); kv_prep(F, a); } } \
        SEAM(ph); } while (0)
    if (lo <= 0 && 0 < hi) { for (int rep_ = 0; rep_ < NREP(0); ++rep_) if (PHM & 1) { KA a = a0; MKCTX(); p0_prologue(F, a); } SEAM(0); }
    { const int l1 = lo > 1 ? lo : 1, h1 = hi < 20 ? hi : 20;
      for (int ph = l1; ph < h1; ++ph) LIGHT_OR_GEMM(ph); }
    if (lo <= 20 && 20 < hi) { for (int rep_ = 0; rep_ < NREP(20); ++rep_) if (PHM & 64) { KA a = a0; MKCTX(); attn_phase(F, a, (char*)lds); } SEAM(20); }
    { const int l2 = lo > 21 ? lo : 21;
      for (int ph = l2; ph < hi; ++ph) LIGHT_OR_GEMM(ph); }
#undef MKCTX
#undef LIGHT_OR_GEMM
#undef SEAM
}

extern "C" void kernel_launch(void* const* d_in, const int* in_sizes, int n_in, void* d_out, int out_size, void* d_ws, size_t ws_size, hipStream_t stream) {
    static int grid = 0;
    if (grid == 0) {
        if (n_in != 29 || ws_size < WS_TOTAL) { fprintf(stderr, "kernel_launch: expected 29 inputs and >= %zu bytes of workspace (got %d, %zu)\n", (size_t)WS_TOTAL, n_in, ws_size); grid = -1; return; }
        int dev = 0, cus = 0, per_cu = 0;
        hipGetDevice(&dev); hipDeviceGetAttribute(&cus, hipDeviceAttributeMultiprocessorCount, dev);
        if (hipFuncSetAttribute((const void*)mk_fwd, hipFuncAttributeMaxDynamicSharedMemorySize, LDS_BYTES) != hipSuccess) { fprintf(stderr, "kernel_launch: hipFuncSetAttribute failed\n"); grid = -1; return; }
        if (hipOccupancyMaxActiveBlocksPerMultiprocessor(&per_cu, (const void*)mk_fwd, 512, LDS_BYTES) != hipSuccess || per_cu < 1) per_cu = 1;
        (void)hipGetLastError();
        grid = cus * 1;
        if (grid <= 0) grid = 256;
    }
    if (grid < 0) return;
    Args a{};
    for (int i = 0; i < 29; ++i) a.in[i] = (const float*)d_in[i];
    a.out = (float*)d_out; a.ws = (unsigned char*)d_ws;
#if MK_PER_PHASE
    for (int p = 0; p < N_PHASES; ++p) { a.ph_lo = p; a.ph_hi = p + 1; hipLaunchKernelGGL(mk_fwd, dim3(grid), dim3(512), LDS_BYTES, stream, a); }
#else
    a.ph_lo = 0; a.ph_hi = N_PHASES;
    if (hipMemsetAsync((char*)d_ws + WS_BAR, 0, 16384, stream) != hipSuccess) { fprintf(stderr, "kernel_launch: memset failed\n"); return; }
    void* args[] = {&a};
    hipError_t e = hipLaunchCooperativeKernel((const void*)mk_fwd, dim3(grid), dim3(512), args, LDS_BYTES, stream);
    if (e != hipSuccess) fprintf(stderr, "kernel_launch: cooperative launch failed: %s (grid %d)\n", hipGetErrorString(e), grid);
#endif
}
```

```cpp
#include <hip/hip_runtime.h>
#include <hip/hip_cooperative_groups.h>
#include <cstdio>
#include <cstdint>
namespace cg = cooperative_groups;

#ifndef MK_PER_PHASE
#define MK_PER_PHASE 0
#endif

#define LAS __attribute__((address_space(3)))
typedef unsigned short bf16_t;
typedef short bf16x8 __attribute__((ext_vector_type(8)));
typedef short s16x4 __attribute__((ext_vector_type(4)));
typedef float f32x2 __attribute__((ext_vector_type(2)));
typedef float f32x4 __attribute__((ext_vector_type(4)));
typedef float f32x16 __attribute__((ext_vector_type(16)));
typedef unsigned u32x2 __attribute__((ext_vector_type(2)));
typedef unsigned u32x4 __attribute__((ext_vector_type(4)));
typedef _Float16 f16x4 __attribute__((ext_vector_type(4)));

constexpr int DM = 1024, NB = 8, SEQ = 4096, CTXL = 256, RPB = SEQ + CTXL, MR = NB * RPB;
constexpr int DFF = 2816, NMODV = 9 * DM;
constexpr int DA = 768, DB = 256, NAB = 2 * DA + DB;
constexpr int NQKV = 1536;
constexpr int NCH = MR / 16, NCHP = 2304, CPB = RPB / 16;
constexpr float EPS = 1e-6f;

constexpr size_t al256(size_t x) { return (x + 255) / 256 * 256; }
constexpr size_t SZ_WFI = (size_t)2 * DFF * DM * 2, SZ_WFO = (size_t)DM * DFF * 2;
constexpr size_t WS_WFI = 0;
constexpr size_t WS_WFO = WS_WFI + 4 * SZ_WFI;
constexpr size_t WS_WABI = WS_WFO + 4 * SZ_WFO;
constexpr size_t WS_WABO = WS_WABI + (size_t)NAB * DM * 2;
constexpr size_t WS_WQKV = WS_WABO + (size_t)DM * DM * 2;
constexpr size_t WS_WAO = WS_WQKV + (size_t)NQKV * DM * 2;
constexpr size_t WS_WGLU = WS_WAO + (size_t)DM * DM * 2;
constexpr size_t WS_WSGU = WS_WGLU + (size_t)DB * DB * 2;
constexpr size_t WS_B1 = WS_WSGU + (size_t)6 * 128 * 128 * 2;
constexpr size_t WS_B2 = WS_B1 + (size_t)16 * 256 * 256 * 2;
constexpr size_t WS_MOD = WS_B2 + (size_t)16 * 256 * 512 * 2;
constexpr size_t WS_ROPE = WS_MOD + al256((size_t)2 * 9 * NMODV * 4);
constexpr size_t WS_XC = WS_ROPE + (size_t)2 * 2048 * 4;
constexpr size_t WS_H = WS_XC + (size_t)MR * DM * 2;
constexpr size_t WS_BIG = WS_H + (size_t)MR * DM * 2;
constexpr size_t WS_Y = WS_BIG + (size_t)MR * DFF * 2;
constexpr size_t WS_S = WS_Y + (size_t)MR * DM * 2;
constexpr size_t WS_END = WS_S + (size_t)16 * NCHP * 256 * 4;
constexpr size_t WS_A2 = WS_Y, WS_YB = WS_A2 + (size_t)16 * NCHP * 512 * 2;
static_assert(WS_YB + (size_t)MR * DB * 2 <= WS_S, "A2 + YB inside Y");
constexpr size_t WS_KB = WS_S, WS_VB = WS_KB + (size_t)NB * 2 * RPB * 128 * 2;
static_assert(WS_VB + (size_t)NB * 2 * RPB * 128 * 2 <= WS_END, "KB + VB inside S");

constexpr size_t WS_BAR = WS_END;
constexpr size_t WS_TOTAL = WS_END + 16384;
static_assert(WS_TOTAL <= (size_t)4 * NB * SEQ * DM * 4, "workspace map must fit in 4x the largest tensor");
constexpr int LDS_BYTES = 147456;

__device__ __forceinline__ unsigned cvt_pk_bf16(float lo, float hi) { unsigned r; asm volatile("v_cvt_pk_bf16_f32 %0, %1, %2" : "=v"(r) : "v"(lo), "v"(hi)); return r; }
__device__ __forceinline__ float bf2f(unsigned short b) { return __uint_as_float((unsigned)b << 16); }
__device__ __forceinline__ float bflo(unsigned w) { return __uint_as_float(w << 16); }
__device__ __forceinline__ float bfhi(unsigned w) { return __uint_as_float(w & 0xffff0000u); }
__device__ __forceinline__ float gelu_tanh(float x) { const float z = x * x * (0.044715f * 2.302208198f) + 2.302208198f;   return x * __builtin_amdgcn_rcpf(1.f + __builtin_amdgcn_exp2f(-x * z)); }
__device__ __forceinline__ float silu_f(float x) { return x * __builtin_amdgcn_rcpf(1.f + __builtin_amdgcn_exp2f(-1.4426950408889634f * x)); }
__device__ __forceinline__ float sigmoid_f(float x) { return __builtin_amdgcn_rcpf(1.f + __builtin_amdgcn_exp2f(-1.4426950408889634f * x)); }
__device__ __forceinline__ float wave_sum(float v) {
#pragma unroll
    for (int o = 1; o < 64; o <<= 1) v += __shfl_xor(v, o);
    return v;
}
#define LDS_WAIT() asm volatile("s_waitcnt lgkmcnt(0)" ::: "memory")
__device__ __forceinline__ int get_tid(int wave_s) { int l; asm volatile("v_mbcnt_lo_u32_b32 %0, -1, 0\n\tv_mbcnt_hi_u32_b32 %0, -1, %0" : "=v"(l)); return wave_s * 64 + l; }

namespace pg8 {
constexpr int BM = 256, BK = 64, HALF = 128, HTB = HALF * BK * 2, STAGE_BYTES = 8 * HTB, NXCD = 8, WGM = 8;
__host__ __device__ __forceinline__ int lds_byte(int r, int c) { const int st = (r >> 4) * 2 + (c >> 5), rr = r & 15, cc = c & 31, ob = rr * 64 + cc * 2; return st * 1024 + (ob ^ (((ob >> 9) & 1) << 5)); }
__host__ __device__ __forceinline__ void stage_rc(int b, int& R, int& C) { const int st = b / 1024, sb = b % 1024, swz = sb ^ (((sb >> 9) & 1) << 5); R = (st >> 1) * 16 + swz / 64; C = (st & 1) * 32 + (swz % 64) / 2; }
__host__ __device__ __forceinline__ int perm32(int rho) { const int n = rho >> 4, i = rho & 15; return 8 * (i >> 2) + 4 * n + (i & 3); }

struct Unit { int pm, pn; };
struct Gemm { const bf16_t* A; const bf16_t* Bt; int lda, ldb, K; };

struct Order {
    int nM, nN, nwg, G, c, kind;
    __device__ void init(int nM_, int nN_, int G_, int c_, int kind_) { nM = nM_; nN = nN_; nwg = nM * nN; G = G_; c = c_; kind = kind_; }
    __device__ bool next(int i, Unit& u) const {
        const long L = (long)i * G + c; if (L >= nwg) return false;
        if (kind == 2) { u.pm = (int)L; u.pn = (int)L / 9; return true; }
        int wgid = (int)L; { const int q = nwg / NXCD, r = nwg % NXCD, xcd = wgid % NXCD, off = wgid / NXCD; wgid = (xcd < r ? xcd * (q + 1) : r * (q + 1) + (xcd - r) * q) + off; }
        const int nig = WGM * nN, gid = wgid / nig, fm = gid * WGM, gsz = (nM - fm) < WGM ? (nM - fm) : WGM;
        int pm = fm + ((wgid % nig) % gsz); u.pn = (wgid % nig) / gsz;
        if (kind == 1) pm = pm + (pm >> 4) + 1;
        u.pm = pm; return true;
    }
};

enum { EM_BF16 = 0, EM_SWIGLU = 1, EM_ABIN = 2, EM_S5G1 = 3, EM_S5G2 = 4, EM_GLU = 5 };
struct Epi {
    static constexpr bool PERM = true;
    int mode; bf16_t* O; int ldc; bf16_t* O2; const bf16_t* aux; const float* bias; float* Of;
    __device__ __forceinline__ void operator()(const f32x4 (&acc)[2][2][4][2], const Unit& u, int wr, int wc, int fr, int fq) const {
        const int row0 = u.pm * BM + wr * 64 + fr, cw = wc * 32 + 8 * fq;
        if (mode == EM_BF16 || (mode == EM_ABIN && u.pn < 6)) {
#pragma unroll
            for (int ai = 0; ai < 2; ++ai)
#pragma unroll
                for (int m = 0; m < 4; ++m) { bf16_t* rowp = O + (size_t)(row0 + ai * HALF + m * 16) * ldc + u.pn * BM + cw;
#pragma unroll
                    for (int bj = 0; bj < 2; ++bj) { const f32x4 v0 = acc[ai][bj][m][0], v1 = acc[ai][bj][m][1];
                        u32x4 w; w.x = cvt_pk_bf16(v0[0], v0[1]); w.y = cvt_pk_bf16(v0[2], v0[3]); w.z = cvt_pk_bf16(v1[0], v1[1]); w.w = cvt_pk_bf16(v1[2], v1[3]);
                        *(u32x4*)(rowp + bj * HALF) = w; } }
        } else if (mode == EM_SWIGLU) {
#pragma unroll
            for (int ai = 0; ai < 2; ++ai)
#pragma unroll
                for (int m = 0; m < 4; ++m) { bf16_t* rowp = O + (size_t)(row0 + ai * HALF + m * 16) * ldc + u.pn * HALF + cw;
                    float r[8];
#pragma unroll
                    for (int n = 0; n < 2; ++n)
#pragma unroll
                        for (int j = 0; j < 4; ++j) r[n * 4 + j] = silu_f(acc[ai][0][m][n][j]) * acc[ai][1][m][n][j];
                    u32x4 w; w.x = cvt_pk_bf16(r[0], r[1]); w.y = cvt_pk_bf16(r[2], r[3]); w.z = cvt_pk_bf16(r[4], r[5]); w.w = cvt_pk_bf16(r[6], r[7]);
                    *(u32x4*)rowp = w; }
        } else if (mode == EM_ABIN) {
#pragma unroll
            for (int ai = 0; ai < 2; ++ai)
#pragma unroll
                for (int m = 0; m < 4; ++m) { const int R = row0 + ai * HALF + m * 16;
#pragma unroll
                    for (int bj = 0; bj < 2; ++bj) { const int col = bj * HALF + cw, g = col >> 4, c0 = col & 15; const f32x4 v0 = acc[ai][bj][m][0], v1 = acc[ai][bj][m][1];
                        u32x4 w; w.x = cvt_pk_bf16(v0[0], v0[1]); w.y = cvt_pk_bf16(v0[2], v0[3]); w.z = cvt_pk_bf16(v1[0], v1[1]); w.w = cvt_pk_bf16(v1[2], v1[3]);
                        *(u32x4*)(O2 + ((size_t)(g * NCHP + (R >> 4)) * 512 + (R & 15) * 16 + c0)) = w; } }
        } else if (mode == EM_S5G1) {
#pragma unroll
            for (int ai = 0; ai < 2; ++ai)
#pragma unroll
                for (int m = 0; m < 4; ++m) { float* rowp = Of + (size_t)(row0 + ai * HALF + m * 16) * 256 + cw;
#pragma unroll
                    for (int bj = 0; bj < 2; ++bj) { *(f32x4*)(rowp + bj * HALF) = acc[ai][bj][m][0]; *(f32x4*)(rowp + bj * HALF + 4) = acc[ai][bj][m][1]; } }
        } else if (mode == EM_S5G2) {
            const int g = u.pn;
#pragma unroll
            for (int ai = 0; ai < 2; ++ai)
#pragma unroll
                for (int m = 0; m < 4; ++m) { const int ch = row0 + ai * HALF + m * 16 - g * NCHP;
                    if (ch < NCH) {
#pragma unroll
                        for (int bj = 0; bj < 2; ++bj) { const int col = bj * HALF + cw, t = col >> 4, c0 = col & 15; const f32x4 v0 = acc[ai][bj][m][0], v1 = acc[ai][bj][m][1];
                            u32x4 w; w.x = cvt_pk_bf16(gelu_tanh(v0[0]), gelu_tanh(v0[1])); w.y = cvt_pk_bf16(gelu_tanh(v0[2]), gelu_tanh(v0[3]));
                            w.z = cvt_pk_bf16(gelu_tanh(v1[0]), gelu_tanh(v1[1])); w.w = cvt_pk_bf16(gelu_tanh(v1[2]), gelu_tanh(v1[3]));
                            *(u32x4*)(O + ((size_t)(ch * 16 + t) * DB + g * 16 + c0)) = w; } } }
        } else {
#pragma unroll
            for (int ai = 0; ai < 2; ++ai)
#pragma unroll
                for (int m = 0; m < 4; ++m) { const size_t R = (size_t)(row0 + ai * HALF + m * 16);
#pragma unroll
                    for (int bj = 0; bj < 2; ++bj) { const int col = bj * HALF + cw; const f32x4 v0 = acc[ai][bj][m][0], v1 = acc[ai][bj][m][1];
                        const u32x4 y = *(const u32x4*)(aux + R * DB + col); const f32x4 b0 = *(const f32x4*)(bias + col), b1 = *(const f32x4*)(bias + col + 4);
                        u32x4 w;
                        w.x = cvt_pk_bf16(bflo(y.x) * sigmoid_f(v0[0] + b0[0]), bfhi(y.x) * sigmoid_f(v0[1] + b0[1]));
                        w.y = cvt_pk_bf16(bflo(y.y) * sigmoid_f(v0[2] + b0[2]), bfhi(y.y) * sigmoid_f(v0[3] + b0[3]));
                        w.z = cvt_pk_bf16(bflo(y.z) * sigmoid_f(v1[0] + b1[0]), bfhi(y.z) * sigmoid_f(v1[1] + b1[1]));
                        w.w = cvt_pk_bf16(bflo(y.w) * sigmoid_f(v1[2] + b1[2]), bfhi(y.w) * sigmoid_f(v1[3] + b1[3]));
                        *(u32x4*)(O2 + R * DM + DA + col) = w; } }
        }
    }
};

template <class Cfg>
__device__ __forceinline__ void gemm_phase(LAS unsigned char* lds, const Cfg cfg) {
    Gemm g; { Order S0; Epi E0; cfg.get(g, S0, E0); }
#define PG8_NEXT(i_, u_) ({ Cfg c2 = cfg; c2.opaque(); Gemm g2; Order S2; Epi E2; c2.get(g2, S2, E2); S2.next(i_, u_); })
    const int tid = get_tid(cfg.wave_s), wid = __builtin_amdgcn_readfirstlane(tid >> 6), lane = tid & 63, wr = wid >> 2, wc = wid & 3, fr = lane & 15, fq = lane >> 4;
    const int K = g.K, nt = K / BK;
    unsigned voffA[2], voffB[2];
#pragma unroll
    for (int i = 0; i < 2; ++i) { int R, C; stage_rc(tid * 16 + i * 8192, R, C); const int Rb = Epi::PERM ? ((R & ~31) + perm32(R & 31)) : R;
        voffA[i] = (unsigned)(R * g.lda + C) * 2u; voffB[i] = (unsigned)(Rb * g.ldb + C) * 2u; }
    const size_t kstep = (size_t)(BK * 2);
    const size_t hstepA = (size_t)HALF * g.lda * 2, hstepB = (size_t)HALF * g.ldb * 2;
    const size_t tstepA = 2 * hstepA, tstepB = 2 * hstepB;
    const unsigned ldsw = (unsigned)wid * 1024u;
    const int aoff = lds_byte(wr * 64 + fr, fq * 8), boff = lds_byte(wc * 32 + fr, fq * 8);
#define PG8_SA(b, h) (((b) * 2 + (h)) * HTB)
#define PG8_SB(b, h) ((4 + (b) * 2 + (h)) * HTB)
#define PG8_STAGE(bufoff, gbase, voff) do { _Pragma("unroll") for (int _i = 0; _i < 2; ++_i) \
        __builtin_amdgcn_global_load_lds((const unsigned*)((const char*)(gbase) + (voff)[_i]), (LAS unsigned*)(lds + (bufoff) + ldsw + _i * 8192), 16, 0, 0); } while (0)
#define PG8_LDA(dst, b, h) do { _Pragma("unroll") for (int m = 0; m < 4; ++m) _Pragma("unroll") for (int k = 0; k < 2; ++k) dst[m][k] = *(const LAS bf16x8*)(lds + PG8_SA(b, h) + aoff + m * 2048 + k * 1024); } while (0)
#define PG8_LDB(dst, b, h) do { _Pragma("unroll") for (int n = 0; n < 2; ++n) _Pragma("unroll") for (int k = 0; k < 2; ++k) dst[n][k] = *(const LAS bf16x8*)(lds + PG8_SB(b, h) + boff + n * 2048 + k * 1024); } while (0)
#define PG8_MMA(ai, bj, At, Bt) do { __builtin_amdgcn_s_setprio(1); _Pragma("unroll") for (int m = 0; m < 4; ++m) _Pragma("unroll") for (int n = 0; n < 2; ++n) _Pragma("unroll") for (int k = 0; k < 2; ++k) \
        acc[ai][bj][m][n] = __builtin_amdgcn_mfma_f32_16x16x32_bf16(Bt[n][k], At[m][k], acc[ai][bj][m][n], 0, 0, 0); __builtin_amdgcn_s_setprio(0); } while (0)
#define PG8_WAIT_V(n) asm volatile("s_waitcnt vmcnt(" #n ")" ::: "memory")
#define PG8_WAIT_L(n) asm volatile("s_waitcnt lgkmcnt(" #n ")" ::: "memory")
#define PG8_BAR __builtin_amdgcn_s_barrier()
#define PG8_SCHED __builtin_amdgcn_sched_barrier(0)
    Unit cur, nxt; int ui = 0;
    if (!PG8_NEXT(0, cur)) return;
    f32x4 acc[2][2][4][2];
#pragma unroll
    for (int a = 0; a < 2; ++a)
#pragma unroll
        for (int b = 0; b < 2; ++b)
#pragma unroll
            for (int m = 0; m < 4; ++m)
#pragma unroll
                for (int n = 0; n < 2; ++n) acc[a][b][m][n] = (f32x4){0.f, 0.f, 0.f, 0.f};
    bf16x8 At[4][2], B0[2][2], B1[2][2];
    const char* cA = (const char*)g.A + (size_t)cur.pm * tstepA; const char* cB = (const char*)g.Bt + (size_t)cur.pn * tstepB;
    PG8_STAGE(PG8_SB(0, 0), cB, voffB); PG8_STAGE(PG8_SB(0, 1), cB + hstepB, voffB); PG8_STAGE(PG8_SA(0, 0), cA, voffA); PG8_STAGE(PG8_SA(0, 1), cA + hstepA, voffA);
    if (wr == 1) PG8_BAR;
    PG8_WAIT_V(2); PG8_BAR;
    PG8_STAGE(PG8_SB(1, 0), cB + kstep, voffB); PG8_STAGE(PG8_SA(1, 0), cA + kstep, voffA); PG8_STAGE(PG8_SB(1, 1), cB + hstepB + kstep, voffB);
    PG8_WAIT_V(6); PG8_BAR;
    for (;;) {
        const bool has_next = PG8_NEXT(ui + 1, nxt);
        const char* nA = has_next ? (const char*)g.A + (size_t)nxt.pm * tstepA : cA; const char* nB = has_next ? (const char*)g.Bt + (size_t)nxt.pn * tstepB : cB;
        for (int t = 0; t < nt; t += 2) {
            const bool last = (t == nt - 2);
            const char* a1 = cA + (size_t)(t + 1) * kstep;
            const char* a2 = last ? nA : cA + (size_t)(t + 2) * kstep; const char* b2 = last ? nB : cB + (size_t)(t + 2) * kstep;
            const char* a3 = a2 + kstep; const char* b3 = b2 + kstep;
            PG8_LDB(B0, 0, 0); PG8_LDB(B1, 0, 1); PG8_SCHED; PG8_LDA(At, 0, 0); PG8_STAGE(PG8_SA(1, 1), a1 + hstepA, voffA);
            PG8_WAIT_V(8); PG8_WAIT_L(0); PG8_BAR; PG8_MMA(0, 0, At, B0); PG8_MMA(0, 1, At, B1); PG8_BAR; PG8_SCHED;
            const bool tail = last && !has_next;
            PG8_LDA(At, 0, 1); if (!tail) { PG8_STAGE(PG8_SB(0, 0), b2, voffB); PG8_STAGE(PG8_SB(0, 1), b2 + hstepB, voffB); PG8_STAGE(PG8_SA(0, 0), a2, voffA); }
            if (tail) PG8_WAIT_V(0); else PG8_WAIT_V(8);
            PG8_WAIT_L(0); PG8_BAR; PG8_MMA(1, 0, At, B0); PG8_MMA(1, 1, At, B1); PG8_BAR; PG8_SCHED;
            PG8_LDB(B0, 1, 0); PG8_LDB(B1, 1, 1); PG8_SCHED; PG8_LDA(At, 1, 0); if (!tail) PG8_STAGE(PG8_SA(0, 1), a2 + hstepA, voffA);
            if (tail) PG8_WAIT_V(0); else PG8_WAIT_V(8);
            PG8_WAIT_L(0); PG8_BAR; PG8_MMA(0, 0, At, B0); PG8_MMA(0, 1, At, B1); PG8_BAR; PG8_SCHED;
            PG8_LDA(At, 1, 1); if (!tail) { PG8_STAGE(PG8_SB(1, 0), b3, voffB); PG8_STAGE(PG8_SB(1, 1), b3 + hstepB, voffB); PG8_STAGE(PG8_SA(1, 0), a3, voffA); }
            if (tail) PG8_WAIT_V(0); else PG8_WAIT_V(8);
            PG8_WAIT_L(0); PG8_BAR; PG8_MMA(1, 0, At, B0); PG8_MMA(1, 1, At, B1); PG8_BAR; PG8_SCHED;
        }
        if (wr == 0) PG8_BAR;
        { Cfg c2 = cfg; c2.opaque(); Gemm g2; Order S2; Epi E2; c2.get(g2, S2, E2); E2(acc, cur, wr, wc, fr, fq); }
        if (!has_next) break;
#pragma unroll
        for (int a = 0; a < 2; ++a)
#pragma unroll
            for (int b = 0; b < 2; ++b)
#pragma unroll
                for (int m = 0; m < 4; ++m)
#pragma unroll
                    for (int n = 0; n < 2; ++n) acc[a][b][m][n] = (f32x4){0.f, 0.f, 0.f, 0.f};
        cur = nxt; cA = nA; cB = nB; ++ui;
        if (wr == 1) PG8_BAR;
    }
    PG8_WAIT_V(0);
    PG8_BAR;
#undef PG8_NEXT
#undef PG8_SA
#undef PG8_SB
#undef PG8_STAGE
#undef PG8_LDA
#undef PG8_LDB
#undef PG8_MMA
#undef PG8_WAIT_V
#undef PG8_WAIT_L
#undef PG8_BAR
#undef PG8_SCHED
}
}

namespace att {
constexpr int D = 128, NW = 8, QBLK = 32, KVBLK = 64;
constexpr float SCALE = 0.088388347648318440f;
constexpr float THR = 8.f;
constexpr int LDQ = NQKV, LDK = 128, LDO = DM;
constexpr size_t SHM_V = KVBLK * D * 2, SHM_K = KVBLK * D * 2, SHM_ATTN = 2 * SHM_V + 2 * SHM_K + NW * 64 * 4;
#define KSWZ(row, colB) ((row) * 256 + ((colB) ^ (((row) & 15) << 4)))
#define SBAR() __builtin_amdgcn_sched_barrier(0)
__device__ __forceinline__ int crow(int r, int hi) { return (r & 3) + 8 * (r >> 2) + 4 * hi; }
__device__ __forceinline__ void partialSM(f32x16& p0) {
#pragma unroll
  for (int r = 0; r < 16; ++r) p0[r] = __builtin_amdgcn_exp2f(p0[r]);
}
__device__ __forceinline__ void finishSM(f32x16& p0, f32x16& p1, float& l_reg, bf16x8& pa0, bf16x8& pa1, bf16x8& pa2, bf16x8& pa3) {
#pragma unroll
  for (int r = 0; r < 16; ++r) p1[r] = __builtin_amdgcn_exp2f(p1[r]);
  float ps = 0;
#pragma unroll
  for (int r = 0; r < 16; ++r) ps += p0[r];
#pragma unroll
  for (int r = 0; r < 16; ++r) ps += p1[r];
  { auto rr = __builtin_amdgcn_permlane32_swap(__float_as_uint(ps), __float_as_uint(ps), false, false);
    ps = __uint_as_float(rr[0]) + __uint_as_float(rr[1]); }
  l_reg += ps;
#define PK4(P, BASE, OUT) do { unsigned a0 = cvt_pk_bf16(P[BASE + 0], P[BASE + 1]), a1 = cvt_pk_bf16(P[BASE + 2], P[BASE + 3]);   \
    unsigned b0 = cvt_pk_bf16(P[BASE + 4], P[BASE + 5]), b1 = cvt_pk_bf16(P[BASE + 6], P[BASE + 7]);                              \
    auto r0 = __builtin_amdgcn_permlane32_swap(a0, b0, false, false); auto r1 = __builtin_amdgcn_permlane32_swap(a1, b1, false, false); \
    u32x4 w = {r0[0], r1[0], r0[1], r1[1]}; OUT = *reinterpret_cast<bf16x8*>(&w); } while (0)
  PK4(p0, 0, pa0); PK4(p0, 8, pa1); PK4(p1, 0, pa2); PK4(p1, 8, pa3);
#undef PK4
}
__device__ __forceinline__ void qkt(f32x16& p0, f32x16& p1, const bf16_t* Ks, const bf16x8* qr, int r32, int hi) {
  p0 = f32x16{}; p1 = f32x16{};
#pragma unroll
  for (int d0 = 0; d0 < 8; ++d0) { int cb = (d0 * 16 + hi * 8) * 2;
    bf16x8 b0 = *reinterpret_cast<const bf16x8*>((const char*)Ks + KSWZ(r32, cb));
    bf16x8 b1 = *reinterpret_cast<const bf16x8*>((const char*)Ks + KSWZ(32 + r32, cb));
    p0 = __builtin_amdgcn_mfma_f32_32x32x16_bf16(b0, qr[d0], p0, 0, 0, 0);
    p1 = __builtin_amdgcn_mfma_f32_32x32x16_bf16(b1, qr[d0], p1, 0, 0, 0); }
}
__device__ __forceinline__ int v_st(int k, int c) { const int kk = (k & ~0xC) | ((k & 4) << 1) | ((k & 8) >> 1); return ((kk >> 3) * 4 + (c >> 5)) * 512 + ((kk & 7) * 32 + (c & 31)) * 2; }
__device__ __forceinline__ int v_rd_base(int lane) { return ((lane & 3) << 3) | (((lane >> 2) & 3) << 6) | (((lane >> 4) & 1) << 5) | (((lane >> 5) & 1) << 8); }
constexpr int v_rd_off(int d0, int ks, int half) { return d0 * 512 + ks * 4096 + half * 2048; }
template <int OFF> __device__ __forceinline__ s16x4 tr_read(int vb) {
  s16x4 r; asm volatile("ds_read_b64_tr_b16 %0, %1 offset:%2" : "=&v"(r) : "v"(vb), "i"(OFF) : "memory"); return r;
}
template <int D0> __device__ __forceinline__ void pv_one(f32x16& od, int vb, bf16x8 pa0, bf16x8 pa1, bf16x8 pa2, bf16x8 pa3) {
  const s16x4 l0 = tr_read<v_rd_off(D0, 0, 0)>(vb), h0 = tr_read<v_rd_off(D0, 0, 1)>(vb), l1 = tr_read<v_rd_off(D0, 1, 0)>(vb), h1 = tr_read<v_rd_off(D0, 1, 1)>(vb);
  const s16x4 l2 = tr_read<v_rd_off(D0, 2, 0)>(vb), h2 = tr_read<v_rd_off(D0, 2, 1)>(vb), l3 = tr_read<v_rd_off(D0, 3, 0)>(vb), h3 = tr_read<v_rd_off(D0, 3, 1)>(vb);
  asm volatile("s_waitcnt lgkmcnt(0)" ::: "memory"); SBAR();
#define PK(L, H) (bf16x8){L[0], L[1], L[2], L[3], H[0], H[1], H[2], H[3]}
  od = __builtin_amdgcn_mfma_f32_32x32x16_bf16(pa0, PK(l0, h0), od, 0, 0, 0);
  od = __builtin_amdgcn_mfma_f32_32x32x16_bf16(pa1, PK(l1, h1), od, 0, 0, 0);
  od = __builtin_amdgcn_mfma_f32_32x32x16_bf16(pa2, PK(l2, h2), od, 0, 0, 0);
  od = __builtin_amdgcn_mfma_f32_32x32x16_bf16(pa3, PK(l3, h3), od, 0, 0, 0);
#undef PK
}
__device__ __forceinline__ void pv_d0(f32x16* o, int vb, bf16x8 pa0, bf16x8 pa1, bf16x8 pa2, bf16x8 pa3) {
  pv_one<0>(o[0], vb, pa0, pa1, pa2, pa3); pv_one<1>(o[1], vb, pa0, pa1, pa2, pa3); pv_one<2>(o[2], vb, pa0, pa1, pa2, pa3); pv_one<3>(o[3], vb, pa0, pa1, pa2, pa3);
}
__device__ __forceinline__ void attn_dense_body(const bf16_t* __restrict__ Qb, const bf16_t* __restrict__ Kh, const bf16_t* __restrict__ Vh,
                                                bf16_t* __restrict__ Ob, int seq, char* lds, int t0, const float* __restrict__ qg, const float* __restrict__ ROPE, int wave_s) {
  const int tid = get_tid(wave_s), wid = tid >> 6, lane = tid & 63, r32 = lane & 31, hi = lane >> 5;
  bf16_t* V_lds = (bf16_t*)lds; bf16_t* K_lds = (bf16_t*)(lds + 2 * SHM_V);
  float* ws = (float*)(lds + 2 * SHM_V + 2 * SHM_K) + wid * 64; float* li_l = ws; float* al_l = ws + 32;
  float l_reg = 0; f32x16 o[4] = {}; bf16x8 qr[8];
  const int sr = tid >> 4, sc = (tid & 15) * 8;
  bf16x8 s0v0, s0v1, s0k0, s0k1, s1v0, s1v1, s1k0, s1k1;
  s0v0 = *reinterpret_cast<const bf16x8*>(&Vh[(long)sr * LDK + sc]); s0v1 = *reinterpret_cast<const bf16x8*>(&Vh[(long)(32 + sr) * LDK + sc]);
  s0k0 = *reinterpret_cast<const bf16x8*>(&Kh[(long)sr * LDK + sc]); s0k1 = *reinterpret_cast<const bf16x8*>(&Kh[(long)(32 + sr) * LDK + sc]);
  {
    const bf16_t* Qw = Qb + (long)(wid * QBLK + r32) * LDQ + hi * 8;
    float qf[8][8]; float ss = 0.f;
#pragma unroll
    for (int d0 = 0; d0 < 8; ++d0) { const u32x4 raw = *reinterpret_cast<const u32x4*>(Qw + d0 * 16);
      qf[d0][0] = bflo(raw.x); qf[d0][1] = bfhi(raw.x); qf[d0][2] = bflo(raw.y); qf[d0][3] = bfhi(raw.y);
      qf[d0][4] = bflo(raw.z); qf[d0][5] = bfhi(raw.z); qf[d0][6] = bflo(raw.w); qf[d0][7] = bfhi(raw.w);
#pragma unroll
      for (int e = 0; e < 8; ++e) ss += qf[d0][e] * qf[d0][e]; }
    { auto rr = __builtin_amdgcn_permlane32_swap(__float_as_uint(ss), __float_as_uint(ss), false, false); ss = __uint_as_float(rr[0]) + __uint_as_float(rr[1]); }
    const float rs = rsqrtf(ss * (1.f / 128.f) + EPS) * (SCALE * 1.4426950408889634f);
#pragma unroll
    for (int d0 = 0; d0 < 8; ++d0) { const f32x4 g0 = *(const f32x4*)(qg + d0 * 16 + hi * 8), g1 = *(const f32x4*)(qg + d0 * 16 + hi * 8 + 4);
#pragma unroll
      for (int e = 0; e < 4; ++e) { qf[d0][e] *= rs * g0[e]; qf[d0][4 + e] *= rs * g1[e]; } }
    const int t = t0 + wid * QBLK + r32;
#pragma unroll
    for (int a = 0; a < 2; ++a) { const int pos = a ? (t & 63) : (t >> 6);
#pragma unroll
      for (int dd = 0; dd < 2; ++dd) { const float* cp = ROPE + pos * 32 + dd * 16 + hi * 8; const float* sp = cp + 2048;
        const f32x4 c0 = *(const f32x4*)cp, c1 = *(const f32x4*)(cp + 4), s0 = *(const f32x4*)sp, s1 = *(const f32x4*)(sp + 4);
#pragma unroll
        for (int e = 0; e < 8; ++e) { const float c = e < 4 ? c0[e & 3] : c1[e & 3], s = e < 4 ? s0[e & 3] : s1[e & 3];
          const float x1 = qf[4 * a + dd][e], x2 = qf[4 * a + 2 + dd][e];
          qf[4 * a + dd][e] = x1 * c - x2 * s; qf[4 * a + 2 + dd][e] = x2 * c + x1 * s; } } }
#pragma unroll
    for (int d0 = 0; d0 < 8; ++d0) { u32x4 w = {cvt_pk_bf16(qf[d0][0], qf[d0][1]), cvt_pk_bf16(qf[d0][2], qf[d0][3]), cvt_pk_bf16(qf[d0][4], qf[d0][5]), cvt_pk_bf16(qf[d0][6], qf[d0][7])};
      qr[d0] = *reinterpret_cast<bf16x8*>(&w); }
  }
  const int vst0 = v_st(sr, sc), vst1 = v_st(32 + sr, sc);
  const int vb0 = (int)(uintptr_t)V_lds + v_rd_base(lane);
#define LD8(p) (*reinterpret_cast<const bf16x8*>(p))
#define SLOAD0(k0) do { s0v0 = LD8(&Vh[(long)((k0) + sr) * LDK + sc]); s0v1 = LD8(&Vh[(long)((k0) + 32 + sr) * LDK + sc]); \
    s0k0 = LD8(&Kh[(long)((k0) + sr) * LDK + sc]); s0k1 = LD8(&Kh[(long)((k0) + 32 + sr) * LDK + sc]); } while (0)
#define SLOAD1(k0) do { s1v0 = LD8(&Vh[(long)((k0) + sr) * LDK + sc]); s1v1 = LD8(&Vh[(long)((k0) + 32 + sr) * LDK + sc]); \
    s1k0 = LD8(&Kh[(long)((k0) + sr) * LDK + sc]); s1k1 = LD8(&Kh[(long)((k0) + 32 + sr) * LDK + sc]); } while (0)
#define SWRITE0(b) do { *(bf16x8*)((char*)V_lds + (b) * SHM_V + vst0) = s0v0; *(bf16x8*)((char*)V_lds + (b) * SHM_V + vst1) = s0v1; const int kc = sc * 2; \
    *(bf16x8*)((char*)K_lds + (b) * SHM_K + KSWZ(sr, kc)) = s0k0; *(bf16x8*)((char*)K_lds + (b) * SHM_K + KSWZ(32 + sr, kc)) = s0k1; } while (0)
#define SWRITE1(b) do { *(bf16x8*)((char*)V_lds + (b) * SHM_V + vst0) = s1v0; *(bf16x8*)((char*)V_lds + (b) * SHM_V + vst1) = s1v1; const int kc = sc * 2; \
    *(bf16x8*)((char*)K_lds + (b) * SHM_K + KSWZ(sr, kc)) = s1k0; *(bf16x8*)((char*)K_lds + (b) * SHM_K + KSWZ(32 + sr, kc)) = s1k1; } while (0)
#define SWAIT() asm volatile("s_waitcnt vmcnt(4)" ::: "memory")
#define RESC(a) do { if (__any((a) < 1.f)) { if (hi == 0) al_l[r32] = (a); asm volatile("s_waitcnt lgkmcnt(0)" ::: "memory"); \
    _Pragma("unroll") for (int d = 0; d < 4; ++d) _Pragma("unroll") for (int r = 0; r < 16; ++r) o[d][r] *= al_l[crow(r, hi)]; } } while (0)
  f32x16 pA0, pA1, pB0, pB1; bf16x8 pa0, pa1, pa2, pa3; const int NT = seq / KVBLK;
  asm volatile("s_waitcnt vmcnt(0)" ::: "memory"); SWRITE0(0); __syncthreads();
  qkt(pA0, pA1, K_lds, qr, r32, hi); partialSM(pA0);
  SLOAD1(KVBLK); SLOAD0(2 * KVBLK);
  SWAIT(); SWRITE1(1); __syncthreads();
  for (int j = 1; j + 1 < NT; j += 2) {
    SBAR(); qkt(pB0, pB1, (bf16_t*)((char*)K_lds + SHM_K), qr, r32, hi);
    finishSM(pA0, pA1, l_reg, pa0, pa1, pa2, pa3); SBAR();
    SLOAD1((j + 2) * KVBLK); SBAR();
    pv_d0(o, vb0, pa0, pa1, pa2, pa3); partialSM(pB0);
    __syncthreads(); SWAIT(); SWRITE0(0);
    SBAR(); __syncthreads();
    SBAR(); qkt(pA0, pA1, K_lds, qr, r32, hi);
    finishSM(pB0, pB1, l_reg, pa0, pa1, pa2, pa3); SBAR();
    if (j + 3 < NT) SLOAD0((j + 3) * KVBLK); SBAR();
    pv_d0(o, vb0 + (int)SHM_V, pa0, pa1, pa2, pa3); partialSM(pA0);
    __syncthreads(); SWAIT(); SWRITE1(1);
    SBAR(); __syncthreads();
  }
  SBAR(); qkt(pB0, pB1, (bf16_t*)((char*)K_lds + SHM_K), qr, r32, hi);
  finishSM(pA0, pA1, l_reg, pa0, pa1, pa2, pa3); SBAR();
  pv_d0(o, vb0, pa0, pa1, pa2, pa3); partialSM(pB0);
  __syncthreads();
  finishSM(pB0, pB1, l_reg, pa0, pa1, pa2, pa3); SBAR();
  pv_d0(o, vb0 + (int)SHM_V, pa0, pa1, pa2, pa3);
  {
    const int tid2 = get_tid(wave_s), lane2 = tid2 & 63, r32b = lane2 & 31, hib = lane2 >> 5;
    float* li2 = (float*)(lds + 2 * SHM_V + 2 * SHM_K) + wave_s * 64;
    if (hib == 0) li2[r32b] = l_reg; asm volatile("s_waitcnt lgkmcnt(0)" ::: "memory");
    float rli[16];
#pragma unroll
    for (int r = 0; r < 16; ++r) rli[r] = __builtin_amdgcn_rcpf(li2[crow(r, hib)]);
    bf16_t* Ow = Ob + (long)(wave_s * QBLK) * LDO;
#pragma unroll
    for (int r = 0; r < 16; ++r) { const int orow = crow(r, hib);
#pragma unroll
      for (int d0 = 0; d0 < 4; ++d0) Ow[(long)orow * LDO + d0 * 32 + r32b] = (bf16_t)(cvt_pk_bf16(o[d0][r] * rli[r], 0.f) & 0xffffu); }
  }
  __syncthreads();
#undef LD8
#undef SLOAD0
#undef SLOAD1
#undef SWRITE0
#undef SWRITE1
#undef SWAIT
#undef RESC
}
}

struct Args { const float* in[29]; float* out; unsigned char* ws; int ph_lo, ph_hi; };
typedef const __attribute__((address_space(4))) Args* KA;
enum { I_X = 0, I_C, I_CTX, I_CCTX, I_WMOD, I_BMOD, I_NPRE, I_NPOST, I_FWI, I_FWO, I_ABWI, I_ABWO, I_SGUG, I_SGUW, I_SGUB, I_LRE, I_LIM, I_LSTEP,
       I_BRE, I_BIM, I_CRE, I_CIM, I_S5D, I_GLUW, I_GLUB, I_WQKV, I_WAO, I_QN, I_KN };

struct Ctx { LAS unsigned char* lds; int tid, lane, wave, vcu, G; };

__device__ __forceinline__ void transpose_item(const float* W, int K, int N, bf16_t* WT, int kind, LAS float* scr, int item, int lane) {
    const int nblk = N / 32, kb = item / nblk, nb = item % nblk, k0 = 64 * kb, n0 = 32 * nb;
#pragma unroll
    for (int i = 0; i < 8; ++i) { const int kk = 8 * i + (lane >> 3), cc = (lane & 7) * 4; const f32x4 w4 = *(const f32x4*)(W + (size_t)(k0 + kk) * N + n0 + cc);
        scr[kk * 33 + cc] = w4.x; scr[kk * 33 + cc + 1] = w4.y; scr[kk * 33 + cc + 2] = w4.z; scr[kk * 33 + cc + 3] = w4.w; }
    LDS_WAIT(); asm volatile("" ::: "memory");
    int r0 = n0;
    if (kind == 1) { const int up = n0 >= DFF ? 1 : 0, h = n0 - up * DFF; r0 = (h >> 7) * 256 + up * 128 + (h & 127); }
    const int c = lane & 7;
#pragma unroll
    for (int j = 0; j < 4; ++j) { const int n = (lane >> 3) + 8 * j; const LAS float* s = scr + (8 * c) * 33 + n;
        u32x4 o; o.x = cvt_pk_bf16(s[0 * 33], s[1 * 33]); o.y = cvt_pk_bf16(s[2 * 33], s[3 * 33]); o.z = cvt_pk_bf16(s[4 * 33], s[5 * 33]); o.w = cvt_pk_bf16(s[6 * 33], s[7 * 33]);
        *(u32x4*)(WT + (size_t)(r0 + n) * K + k0 + 8 * c) = o; }
    LDS_WAIT(); asm volatile("" ::: "memory");
}

__device__ __forceinline__ void s5_matrices(const Ctx& F, KA a, int g) {
    LAS float* LP = (LAS float*)F.lds;
    LAS float* BB = LP + 2 * 17 * 64 * 2;
    LAS float* CC = BB + 2 * 64 * 16 * 2;
    LAS float* KT = CC + 2 * 16 * 64 * 2;
    const float* lre = a->in[I_LRE]; const float* lim = a->in[I_LIM]; const float* lst = a->in[I_LSTEP];
    const float* bre = a->in[I_BRE]; const float* bim = a->in[I_BIM]; const float* cre = a->in[I_CRE]; const float* cim = a->in[I_CIM]; const float* dsk = a->in[I_S5D];
    if (F.tid < 128) {
        const int dir = F.tid >> 6, p = F.tid & 63; const int gi = (dir * 16 + g);
        const float lr = lre[gi * 64 + p], li = lim[gi * 64 + p], dt = expf(lst[gi]);
        const float mag = expf(lr * dt); float sn, cs; sincosf(li * dt, &sn, &cs);
        const float br = mag * cs, bi = mag * sn;
        float pr = 1.f, pi = 0.f;
        for (int tau = 0; tau <= 16; ++tau) { LP[((dir * 17 + tau) * 64 + p) * 2] = pr; LP[((dir * 17 + tau) * 64 + p) * 2 + 1] = pi;
            const float nr = pr * br - pi * bi, ni = pr * bi + pi * br; pr = nr; pi = ni; }
        const float ar = br - 1.f, ai = bi, den = lr * lr + li * li; const float zr = (ar * lr + ai * li) / den, zi = (ai * lr - ar * li) / den;
        for (int c = 0; c < 16; ++c) { const float xr = bre[(gi * 64 + p) * 16 + c], xi = bim[(gi * 64 + p) * 16 + c];
            BB[((dir * 64 + p) * 16 + c) * 2] = zr * xr - zi * xi; BB[((dir * 64 + p) * 16 + c) * 2 + 1] = zr * xi + zi * xr; }
        for (int c = 0; c < 16; ++c) { CC[((dir * 16 + c) * 64 + p) * 2] = cre[(gi * 16 + c) * 64 + p]; CC[((dir * 16 + c) * 64 + p) * 2 + 1] = cim[(gi * 16 + c) * 64 + p]; }
    }
    __syncthreads();
    for (int e = F.tid; e < 2 * 16 * 256; e += 512) {
        const int dir = e >> 12, tau = (e >> 8) & 15, c = (e >> 4) & 15, c2 = e & 15; float s = 0.f;
        for (int p = 0; p < 64; ++p) { const float cr = CC[((dir * 16 + c) * 64 + p) * 2], ci = CC[((dir * 16 + c) * 64 + p) * 2 + 1];
            const float lr = LP[((dir * 17 + tau) * 64 + p) * 2], li = LP[((dir * 17 + tau) * 64 + p) * 2 + 1];
            const float xr = BB[((dir * 64 + p) * 16 + c2) * 2], xi = BB[((dir * 64 + p) * 16 + c2) * 2 + 1];
            const float mr = cr * lr - ci * li, mi = cr * li + ci * lr; s += mr * xr - mi * xi; }
        KT[e] = s;
    }
    __syncthreads();
    bf16_t* B1 = (bf16_t*)(a->ws + WS_B1) + (size_t)g * 256 * 256; bf16_t* B2 = (bf16_t*)(a->ws + WS_B2) + (size_t)g * 256 * 512;
    for (int e = F.tid; e < 256 * 128; e += 512) {
        const int n = e >> 7, k = (e & 127) * 2, dir = n >> 7, p = (n & 127) >> 1, ri = n & 1, s = k >> 4, c2 = k & 15, pw = dir ? s : 15 - s;
        const float lr = LP[((dir * 17 + pw) * 64 + p) * 2], li = LP[((dir * 17 + pw) * 64 + p) * 2 + 1]; float v[2];
#pragma unroll
        for (int q = 0; q < 2; ++q) { const float xr = BB[((dir * 64 + p) * 16 + c2 + q) * 2], xi = BB[((dir * 64 + p) * 16 + c2 + q) * 2 + 1];
            v[q] = ri ? (lr * xi + li * xr) : (lr * xr - li * xi); }
        *(unsigned*)(B1 + (size_t)n * 256 + k) = cvt_pk_bf16(v[0], v[1]);
    }
    for (int e = F.tid; e < 256 * 256; e += 512) {
        const int n = e >> 8, k = (e & 255) * 2, t = n >> 4, c = n & 15; float v[2];
        if (k < 256) { const int s = k >> 4, c2 = k & 15;
#pragma unroll
            for (int q = 0; q < 2; ++q) { float x = 0.f; if (s <= t) x += KT[((0 * 16 + (t - s)) * 16 + c) * 16 + c2 + q]; if (s >= t) x += KT[((1 * 16 + (s - t)) * 16 + c) * 16 + c2 + q];
                if (s == t && c == c2 + q) x += dsk[g * 16 + c]; v[q] = x; }
        } else { const int kk = k - 256, dir = kk >> 7, p = (kk & 127) >> 1, pw = dir ? 16 - t : t + 1;
            const float lr = LP[((dir * 17 + pw) * 64 + p) * 2], li = LP[((dir * 17 + pw) * 64 + p) * 2 + 1];
            const float cr = CC[((dir * 16 + c) * 64 + p) * 2], ci = CC[((dir * 16 + c) * 64 + p) * 2 + 1];
            v[0] = cr * lr - ci * li; v[1] = -(cr * li + ci * lr); }
        *(unsigned*)(B2 + (size_t)n * 512 + k) = cvt_pk_bf16(v[0], v[1]);
    }
    __syncthreads();
}

__device__ __forceinline__ void mod_gemv(const Ctx& F, KA a) {
    LAS float* sl = (LAS float*)F.lds;
    LAS float* part = sl + 9 * 1024;
    for (int e = F.tid; e < 9 * 1024; e += 512) { const float v = e < 8192 ? a->in[I_C][e] : a->in[I_CCTX][e - 8192]; sl[e] = silu_f(v); }
    __syncthreads();
    float* MOD = (float*)(a->ws + WS_MOD);
    const int skip = F.G >= 64 ? 16 : 0;
    for (int task = (int)blockIdx.x - skip; task >= 0 && task < 288; task += F.G - skip) {
        const int i = task / 144, nb = task % 144;
        const float* w = a->in[I_WMOD] + (size_t)i * DM * NMODV + nb * 64 + F.lane;
        float acc[9];
#pragma unroll
        for (int r = 0; r < 9; ++r) acc[r] = 0.f;
        for (int kk = 0; kk < 128; kk += 16) { float wv[16];
#pragma unroll
            for (int u = 0; u < 16; ++u) wv[u] = w[(size_t)(F.wave * 128 + kk + u) * NMODV];
#pragma unroll
            for (int u = 0; u < 16; ++u)
#pragma unroll
                for (int r = 0; r < 9; ++r) acc[r] += sl[r * 1024 + F.wave * 128 + kk + u] * wv[u]; }
#pragma unroll
        for (int r = 0; r < 9; ++r) part[(F.wave * 9 + r) * 64 + F.lane] = acc[r];
        __syncthreads();
        for (int e = F.tid; e < 576; e += 512) { const int r = e >> 6, l = e & 63; float s = a->in[I_BMOD][i * NMODV + nb * 64 + l];
#pragma unroll
            for (int w8 = 0; w8 < 8; ++w8) s += part[(w8 * 9 + r) * 64 + l];
            MOD[(size_t)(i * 9 + r) * NMODV + nb * 64 + l] = s; }
        __syncthreads();
    }
}

__device__ __forceinline__ void p0_prologue(const Ctx& F, KA a) {
    if ((int)blockIdx.x < 16) s5_matrices(F, a, (int)blockIdx.x);
    if ((int)blockIdx.x == 16 % F.G) {
        float* RT = (float*)(a->ws + WS_ROPE);
        for (int e = F.tid; e < 2048; e += 512) { const int pos = e >> 5, f = e & 31; const float inv = powf(10000.f, -(float)(2 * f) / 64.f); const float ang = (float)pos * inv;
            float sn, cs; sincosf(ang, &sn, &cs); RT[e] = cs; RT[2048 + e] = sn; }
    }
    mod_gemv(F, a);
    LAS float* scr = (LAS float*)(F.lds + F.wave * 16384);
    const int skip = F.G >= 64 ? 16 : 0;
    const int gw = ((int)blockIdx.x - skip) * 8 + F.wave, NGW = (F.G - skip) * 8;
    constexpr int I_FI = (DM / 64) * (2 * DFF / 32), I_FO = (DFF / 64) * (DM / 32), I_ABI = (DM / 64) * (NAB / 32), I_SQ = (DM / 64) * (DM / 32), I_QKV = (DM / 64) * (NQKV / 32), I_GLU = (DB / 64) * (DB / 32);
    constexpr int NITEMS = 4 * I_FI + 4 * I_FO + I_ABI + I_SQ + I_QKV + I_SQ + I_GLU;
    for (int it = gw; it >= 0 && it < NITEMS; it += NGW) {
        int r = it;
        if (r < 4 * I_FI) { const int q = r / I_FI; transpose_item(a->in[I_FWI] + (size_t)q * DM * 2 * DFF, DM, 2 * DFF, (bf16_t*)(a->ws + WS_WFI + q * SZ_WFI), 1, scr, r % I_FI, F.lane); continue; } r -= 4 * I_FI;
        if (r < 4 * I_FO) { const int q = r / I_FO; transpose_item(a->in[I_FWO] + (size_t)q * DFF * DM, DFF, DM, (bf16_t*)(a->ws + WS_WFO + q * SZ_WFO), 0, scr, r % I_FO, F.lane); continue; } r -= 4 * I_FO;
        if (r < I_ABI) { transpose_item(a->in[I_ABWI], DM, NAB, (bf16_t*)(a->ws + WS_WABI), 0, scr, r, F.lane); continue; } r -= I_ABI;
        if (r < I_SQ) { transpose_item(a->in[I_ABWO], DM, DM, (bf16_t*)(a->ws + WS_WABO), 0, scr, r, F.lane); continue; } r -= I_SQ;
        if (r < I_QKV) { transpose_item(a->in[I_WQKV], DM, NQKV, (bf16_t*)(a->ws + WS_WQKV), 0, scr, r, F.lane); continue; } r -= I_QKV;
        if (r < I_SQ) { transpose_item(a->in[I_WAO], DM, DM, (bf16_t*)(a->ws + WS_WAO), 0, scr, r, F.lane); continue; } r -= I_SQ;
        transpose_item(a->in[I_GLUW], DB, DB, (bf16_t*)(a->ws + WS_WGLU), 0, scr, r, F.lane);
    }
    { const float* src = a->in[I_SGUW]; bf16_t* dst = (bf16_t*)(a->ws + WS_WSGU);
      for (int e = (blockIdx.x * 512 + F.tid) * 2; e < 6 * 128 * 128; e += F.G * 512 * 2) *(unsigned*)(dst + e) = cvt_pk_bf16(src[e], src[e + 1]); }
}

struct Ew { const float* xl; const float* xc; const _Float16* xh; _Float16* oh; float* of; const bf16_t* Y; const float* gpost; const float* gate; float w;
            const float* gpre; const float* shift; const float* scale; bf16_t* H; int latent_only; };
__device__ __forceinline__ void ew_pass(const Ctx& F, const Ew& e) {
    constexpr int NR = 4;
    typedef _Float16 f16x8 __attribute__((ext_vector_type(8))); typedef float f32x8 __attribute__((ext_vector_type(8)));
    const int gw = F.vcu * 8 + F.wave, NGW = F.G * 8;
    const bool hasY = e.Y != nullptr, f32src = e.xl != nullptr, hasH = e.H != nullptr;
    LAS f32x4* PA = (LAS f32x4*)F.lds; LAS f32x4* PB = PA + 9 * 256; LAS f32x4* PC = PB + 9 * 256;
    { const float* p_gpost = e.gpost; const float* p_gate = e.gate; const float* p_gpre = e.gpre; const float* p_scale = e.scale; const float* p_shift = e.shift; float wgt = e.w;
      asm volatile("" : "+s"(p_gpost), "+s"(p_gate), "+s"(p_gpre), "+s"(p_scale), "+s"(p_shift), "+s"(wgt));
      for (int idx = F.tid; idx < 9 * 256; idx += 512) { const int r = idx >> 8, c = (idx >> 6) & 3, l = idx & 63, c4 = (c >> 1) * 128 + l * 2 + (c & 1);
        if (hasY) PA[idx] = ((const f32x4*)p_gpost)[c4] * ((const f32x4*)(p_gate + (size_t)r * NMODV))[c4] * wgt;
        if (hasH) { PB[idx] = ((const f32x4*)p_gpre)[c4] * (((const f32x4*)(p_scale + (size_t)r * NMODV))[c4] + 1.f); PC[idx] = ((const f32x4*)(p_shift + (size_t)r * NMODV))[c4]; } } }
    __syncthreads();
    for (int R0 = gw; R0 < MR; R0 += NR * NGW) {
        f32x4 v[NR][4]; u32x4 yw[NR][2]; bool act[NR]; size_t xoff[NR]; int mrow[NR]; bool isc[NR];
#pragma unroll
        for (int k = 0; k < NR; ++k) {
            const int R = R0 + k * NGW; const int Rc = R < MR ? R : 0; const int b = Rc / RPB, j = Rc - b * RPB; isc[k] = j < CTXL;
            act[k] = (R < MR) && !(isc[k] && e.latent_only);
            xoff[k] = isc[k] ? (size_t)(b * CTXL + j) * DM : (size_t)(b * SEQ + j - CTXL) * DM; mrow[k] = isc[k] ? 8 : b;
            if (act[k]) {
                if (f32src) { const f32x4* xr = (const f32x4*)((isc[k] ? e.xc : e.xl) + xoff[k]) + F.lane * 2;
#pragma unroll
                    for (int c = 0; c < 4; ++c) v[k][c] = __builtin_nontemporal_load(xr + (c >> 1) * 128 + (c & 1)); }
                else { const f16x8* xr = (const f16x8*)(e.xh + (size_t)Rc * DM) + F.lane;
#pragma unroll
                    for (int q = 0; q < 2; ++q) { const f32x8 t = __builtin_convertvector(__builtin_nontemporal_load(xr + 64 * q), f32x8);
                        v[k][2 * q] = (f32x4){t[0], t[1], t[2], t[3]}; v[k][2 * q + 1] = (f32x4){t[4], t[5], t[6], t[7]}; } }
                if (hasY) { const u32x4* yr = (const u32x4*)(e.Y + (size_t)Rc * DM) + F.lane;
#pragma unroll
                    for (int q = 0; q < 2; ++q) yw[k][q] = __builtin_nontemporal_load(yr + 64 * q); }
            }
        }
#pragma unroll
        for (int k = 0; k < NR; ++k) {
            if (!act[k]) continue;
            const int R = R0 + k * NGW;
            if (hasY) {
                f32x4 y[4]; float ss = 0.f;
#pragma unroll
                for (int q = 0; q < 2; ++q) { const u32x4 w = yw[k][q]; y[2 * q] = (f32x4){bflo(w.x), bfhi(w.x), bflo(w.y), bfhi(w.y)}; y[2 * q + 1] = (f32x4){bflo(w.z), bfhi(w.z), bflo(w.w), bfhi(w.w)}; }
#pragma unroll
                for (int c = 0; c < 4; ++c) ss += (y[c].x * y[c].x + y[c].y * y[c].y) + (y[c].z * y[c].z + y[c].w * y[c].w);
                const float rs = rsqrtf(wave_sum(ss) * (1.f / DM) + EPS);
                const LAS f32x4* pa = PA + mrow[k] * 256 + F.lane;
#pragma unroll
                for (int c = 0; c < 4; ++c) v[k][c] += (y[c] * rs) * pa[64 * c];
            }
            if (e.oh) { f16x8* o = (f16x8*)(e.oh + (size_t)R * DM) + F.lane;
#pragma unroll
                for (int q = 0; q < 2; ++q) { const f32x4 a0 = v[k][2 * q], a1 = v[k][2 * q + 1]; const f32x8 t = {a0.x, a0.y, a0.z, a0.w, a1.x, a1.y, a1.z, a1.w};
                    __builtin_nontemporal_store(__builtin_convertvector(t, f16x8), o + 64 * q); } }
            if (e.of) { f32x4* o = (f32x4*)(e.of + xoff[k]) + F.lane * 2;
#pragma unroll
                for (int c = 0; c < 4; ++c) __builtin_nontemporal_store(v[k][c], o + (c >> 1) * 128 + (c & 1)); }
            if (hasH) {
                float ss = 0.f;
#pragma unroll
                for (int c = 0; c < 4; ++c) ss += (v[k][c].x * v[k][c].x + v[k][c].y * v[k][c].y) + (v[k][c].z * v[k][c].z + v[k][c].w * v[k][c].w);
                const float rs = rsqrtf(wave_sum(ss) * (1.f / DM) + EPS);
                const LAS f32x4* pb = PB + mrow[k] * 256 + F.lane; const LAS f32x4* pc = PC + mrow[k] * 256 + F.lane;
                u32x4* h = (u32x4*)(e.H + (size_t)R * DM) + F.lane;
#pragma unroll
                for (int q = 0; q < 2; ++q) { const f32x4 t0 = (v[k][2 * q] * rs) * pb[64 * (2 * q)] + pc[64 * (2 * q)], t1 = (v[k][2 * q + 1] * rs) * pb[64 * (2 * q + 1)] + pc[64 * (2 * q + 1)];
                    u32x4 w; w.x = cvt_pk_bf16(t0.x, t0.y); w.y = cvt_pk_bf16(t0.z, t0.w); w.z = cvt_pk_bf16(t1.x, t1.y); w.w = cvt_pk_bf16(t1.z, t1.w); h[64 * q] = w; }
            }
        }
    }
}

__device__ __forceinline__ void sgu_phase(const Ctx& F, KA a, int first, int stride, int last) {
    constexpr int LDO = 136;
    const bf16_t* P = (const bf16_t*)(a->ws + WS_BIG); bf16_t* MIX = (bf16_t*)(a->ws + WS_H); const bf16_t* W = (const bf16_t*)(a->ws + WS_WSGU);
    const float* gam = a->in[I_SGUG]; const float* sb = a->in[I_SGUB];
    const int l16 = F.tid & 15, srow = F.tid >> 4, hi = F.lane >> 5, r32 = F.lane & 31, tq = F.wave >> 1, chh = F.wave & 1;
    const int vb = (int)(uintptr_t)(unsigned char*)F.lds + att::v_rd_base(F.lane);
    LAS bf16_t* OUT = (LAS bf16_t*)(F.lds + 32768);
    const int NU = last < (MR / 128) * 6 ? last : (MR / 128) * 6;
    u32x4 rv[4], ru[4];
    if (first < NU) { const int n = first / 6, g = first - n * 6;
#pragma unroll
        for (int pass = 0; pass < 4; ++pass) { const bf16_t* p = P + (size_t)(n * 128 + pass * 32 + srow) * 1536 + g * 128 + l16 * 8; rv[pass] = *(const u32x4*)(p + DA); ru[pass] = *(const u32x4*)p; } }
    for (int unit = first; unit < NU; unit += stride) {
        const int n = unit / 6, g = unit - n * 6;
        u32x4 gu[4];
        const f32x4 g0 = *(const f32x4*)(gam + g * 128 + l16 * 8), g1 = *(const f32x4*)(gam + g * 128 + l16 * 8 + 4);
#pragma unroll
        for (int pass = 0; pass < 4; ++pass) { const int s = pass * 32 + srow; const u32x4 raw = rv[pass];
            float v[8] = {bflo(raw.x), bfhi(raw.x), bflo(raw.y), bfhi(raw.y), bflo(raw.z), bfhi(raw.z), bflo(raw.w), bfhi(raw.w)}; float sm = 0.f;
#pragma unroll
            for (int q = 0; q < 8; ++q) { v[q] = gelu_tanh(v[q]); sm += v[q]; }
            sm += __shfl_xor(sm, 1); sm += __shfl_xor(sm, 2); sm += __shfl_xor(sm, 4); sm += __shfl_xor(sm, 8);
            const float mu = sm * (1.f / 128.f); float vq = 0.f;
#pragma unroll
            for (int q = 0; q < 8; ++q) { v[q] -= mu; vq += v[q] * v[q]; }
            vq += __shfl_xor(vq, 1); vq += __shfl_xor(vq, 2); vq += __shfl_xor(vq, 4); vq += __shfl_xor(vq, 8);
            const float rs = rsqrtf(vq * (1.f / 128.f) + EPS);
            u32x4 w; w.x = cvt_pk_bf16(v[0] * rs * g0[0], v[1] * rs * g0[1]); w.y = cvt_pk_bf16(v[2] * rs * g0[2], v[3] * rs * g0[3]);
            w.z = cvt_pk_bf16(v[4] * rs * g1[0], v[5] * rs * g1[1]); w.w = cvt_pk_bf16(v[6] * rs * g1[2], v[7] * rs * g1[3]);
            *(LAS u32x4*)(F.lds + (s >> 6) * 16384 + att::v_st(s & 63, l16 * 8)) = w;
            const u32x4 u = ru[pass];
            gu[pass].x = cvt_pk_bf16(gelu_tanh(bflo(u.x)), gelu_tanh(bfhi(u.x))); gu[pass].y = cvt_pk_bf16(gelu_tanh(bflo(u.y)), gelu_tanh(bfhi(u.y)));
            gu[pass].z = cvt_pk_bf16(gelu_tanh(bflo(u.z)), gelu_tanh(bfhi(u.z))); gu[pass].w = cvt_pk_bf16(gelu_tanh(bflo(u.w)), gelu_tanh(bfhi(u.w)));
        }
        { const int nu = unit + stride;
          if (nu < NU) { const int n2 = nu / 6, g2 = nu - n2 * 6;
#pragma unroll
            for (int pass = 0; pass < 4; ++pass) { const bf16_t* p = P + (size_t)(n2 * 128 + pass * 32 + srow) * 1536 + g2 * 128 + l16 * 8; rv[pass] = *(const u32x4*)(p + DA); ru[pass] = *(const u32x4*)p; } } }
        const bf16_t* Wg = W + (size_t)g * 128 * 128 + (size_t)(tq * 32 + r32) * 128 + hi * 8;
        bf16x8 wf[2][4];
#pragma unroll
        for (int tile = 0; tile < 2; ++tile)
#pragma unroll
            for (int ks = 0; ks < 4; ++ks) wf[tile][ks] = *(const bf16x8*)(Wg + tile * 64 + ks * 16);
        float bs[16];
#pragma unroll
        for (int r = 0; r < 16; ++r) bs[r] = sb[g * 128 + tq * 32 + att::crow(r, hi)];
        __syncthreads();
        f32x16 acc0 = {}, acc1 = {};
#pragma unroll
        for (int tile = 0; tile < 2; ++tile) {
            if (chh == 0) { att::pv_one<0>(acc0, vb + tile * 16384, wf[tile][0], wf[tile][1], wf[tile][2], wf[tile][3]); att::pv_one<1>(acc1, vb + tile * 16384, wf[tile][0], wf[tile][1], wf[tile][2], wf[tile][3]); }
            else { att::pv_one<2>(acc0, vb + tile * 16384, wf[tile][0], wf[tile][1], wf[tile][2], wf[tile][3]); att::pv_one<3>(acc1, vb + tile * 16384, wf[tile][0], wf[tile][1], wf[tile][2], wf[tile][3]); }
        }
#pragma unroll
        for (int r = 0; r < 16; ++r) { const int t = tq * 32 + att::crow(r, hi); const float bias = bs[r];
            OUT[t * LDO + chh * 64 + r32] = (bf16_t)(cvt_pk_bf16(acc0[r] + bias, 0.f) & 0xffffu); OUT[t * LDO + chh * 64 + 32 + r32] = (bf16_t)(cvt_pk_bf16(acc1[r] + bias, 0.f) & 0xffffu); }
        __syncthreads();
#pragma unroll
        for (int pass = 0; pass < 4; ++pass) { const int t = pass * 32 + srow; const u32x4 m = *(const LAS u32x4*)(OUT + t * LDO + l16 * 8); const u32x4 u = gu[pass]; u32x4 w;
            w.x = cvt_pk_bf16(bflo(u.x) * bflo(m.x), bfhi(u.x) * bfhi(m.x)); w.y = cvt_pk_bf16(bflo(u.y) * bflo(m.y), bfhi(u.y) * bfhi(m.y));
            w.z = cvt_pk_bf16(bflo(u.z) * bflo(m.z), bfhi(u.z) * bfhi(m.z)); w.w = cvt_pk_bf16(bflo(u.w) * bflo(m.w), bfhi(u.w) * bfhi(m.w));
            *(u32x4*)(MIX + (size_t)(n * 128 + t) * DM + g * 128 + l16 * 8) = w; }
    }
    __syncthreads();
}

__device__ __forceinline__ void s5_scan(const Ctx& F, KA a) {
    constexpr int SEG = CPB / 8;
    const float* S = (const float*)(a->ws + WS_S); bf16_t* A2 = (bf16_t*)(a->ws + WS_A2);
    LAS float* seg = (LAS float*)(F.lds + 69632);
    for (int task = F.vcu; task < NB * 16 * 2; task += F.G) {
        const int dir = task & 1, g = (task >> 1) & 15, b = task >> 5, p = F.lane, w = F.wave; const int gi = dir * 16 + g;
        const float lr = a->in[I_LRE][gi * 64 + p], li = a->in[I_LIM][gi * 64 + p], dt = expf(a->in[I_LSTEP][gi]);
        const float mag = expf(lr * dt); float sn, cs; sincosf(li * dt, &sn, &cs);
        float ar = mag * cs, ai = mag * sn;
#pragma unroll
        for (int q = 0; q < 4; ++q) { const float nr = ar * ar - ai * ai, ni = 2.f * ar * ai; ar = nr; ai = ni; }
        f32x2 sv[SEG];
#pragma unroll
        for (int u = 0; u < SEG; ++u) { const int k = w * SEG + u, nat = dir ? (k < 16 ? 15 - k : 287 - k) : k;
            sv[u] = *(const f32x2*)(S + ((size_t)(g * NCHP + b * CPB + nat) * 256 + dir * 128 + 2 * p)); }
        float hr = 0.f, hi_ = 0.f, qr = 1.f, qi = 0.f;
#pragma unroll
        for (int u = 0; u < SEG; ++u) { const float nr = ar * hr - ai * hi_ + sv[u].x, ni = ar * hi_ + ai * hr + sv[u].y; hr = nr; hi_ = ni;
            const float tr = qr * ar - qi * ai, ti = qr * ai + qi * ar; qr = tr; qi = ti; }
        seg[(w * 64 + p) * 2] = hr; seg[(w * 64 + p) * 2 + 1] = hi_;
        __syncthreads();
        float cr = 0.f, ci = 0.f;
        for (int v = 0; v < w; ++v) { const float fr_ = seg[(v * 64 + p) * 2], fi_ = seg[(v * 64 + p) * 2 + 1]; const float nr = qr * cr - qi * ci + fr_, ni = qr * ci + qi * cr + fi_; cr = nr; ci = ni; }
        hr = cr; hi_ = ci;
#pragma unroll
        for (int u = 0; u < SEG; ++u) { const int k = w * SEG + u, nat = dir ? (k < 16 ? 15 - k : 287 - k) : k;
            *(unsigned*)(A2 + ((size_t)(g * NCHP + b * CPB + nat) * 512 + 256 + dir * 128 + 2 * p)) = cvt_pk_bf16(hr, hi_);
            const float nr = ar * hr - ai * hi_ + sv[u].x, ni = ar * hi_ + ai * hr + sv[u].y; hr = nr; hi_ = ni; }
        __syncthreads();
    }
}

__device__ __forceinline__ void kv_prep(const Ctx& F, KA a) {
    constexpr int NR = 4;
    const int gw = F.vcu * 8 + F.wave, NGW = F.G * 8;
    const bf16_t* QKV = (const bf16_t*)(a->ws + WS_BIG); bf16_t* KB = (bf16_t*)(a->ws + WS_KB); bf16_t* VB = (bf16_t*)(a->ws + WS_VB);
    const float* RT = (const float*)(a->ws + WS_ROPE); const float* kg = a->in[I_KN];
    const int seg = F.lane >> 4, l16 = F.lane & 15;
    const f32x4 g0 = *(const f32x4*)(kg + l16 * 8), g1 = *(const f32x4*)(kg + l16 * 8 + 4);
    for (int R0 = gw; R0 < MR; R0 += NR * NGW) {
        u32x4 raws[NR];
#pragma unroll
        for (int k = 0; k < NR; ++k) { const int R = R0 + k * NGW; if (R < MR) raws[k] = *(const u32x4*)(QKV + (size_t)R * NQKV + 1024 + seg * 128 + l16 * 8); }
#pragma unroll
        for (int k = 0; k < NR; ++k) { const int R = R0 + k * NGW; if (R >= MR) continue;
            const int b = R / RPB, j = R - b * RPB; const bool lat = j >= CTXL; const int t = j - CTXL; const u32x4 raw = raws[k];
            float f[8] = {bflo(raw.x), bfhi(raw.x), bflo(raw.y), bfhi(raw.y), bflo(raw.z), bfhi(raw.z), bflo(raw.w), bfhi(raw.w)}; float ss = 0.f;
#pragma unroll
            for (int q = 0; q < 8; ++q) ss += f[q] * f[q];
            ss += __shfl_xor(ss, 1); ss += __shfl_xor(ss, 2); ss += __shfl_xor(ss, 4); ss += __shfl_xor(ss, 8);
            const float rs = rsqrtf(ss * (1.f / 128.f) + EPS);
            float pf[8];
#pragma unroll
            for (int q = 0; q < 8; ++q) { f[q] *= rs * (q < 4 ? g0[q & 3] : g1[q & 3]); pf[q] = __shfl_xor(f[q], 4); }
            if (lat) { const int ax = l16 >> 3, pos = ax ? (t & 63) : (t >> 6); const bool first = (l16 & 7) < 4; const int fb = (l16 & 3) * 8;
                const f32x4 c0 = *(const f32x4*)(RT + pos * 32 + fb), c1 = *(const f32x4*)(RT + pos * 32 + fb + 4), s0 = *(const f32x4*)(RT + 2048 + pos * 32 + fb), s1 = *(const f32x4*)(RT + 2048 + pos * 32 + fb + 4);
#pragma unroll
                for (int q = 0; q < 8; ++q) { const float c = q < 4 ? c0[q & 3] : c1[q & 3], sn = q < 4 ? s0[q & 3] : s1[q & 3]; f[q] = first ? f[q] * c - pf[q] * sn : f[q] * c + pf[q] * sn; } }
            u32x4 w; w.x = cvt_pk_bf16(f[0], f[1]); w.y = cvt_pk_bf16(f[2], f[3]); w.z = cvt_pk_bf16(f[4], f[5]); w.w = cvt_pk_bf16(f[6], f[7]);
            if (seg < 2) *(u32x4*)(KB + ((size_t)((b * 2 + seg) * RPB + j) * 128 + l16 * 8)) = w;
            else *(u32x4*)(VB + ((size_t)((b * 2 + seg - 2) * RPB + j) * 128 + l16 * 8)) = raw;
        }
    }
}

__device__ __forceinline__ void attn_phase(const Ctx& F, KA a, char* lds_generic) {
    const bf16_t* QKV = (const bf16_t*)(a->ws + WS_BIG); const bf16_t* KB = (const bf16_t*)(a->ws + WS_KB); const bf16_t* VB = (const bf16_t*)(a->ws + WS_VB);
    bf16_t* O = (bf16_t*)(a->ws + WS_H); const float* RT = (const float*)(a->ws + WS_ROPE);
    int seq_ = RPB; asm volatile("" : "+s"(seq_));
    for (int i = 0;; ++i) {
        int uidx;
        if (F.G == 256) { const int x = F.vcu >> 5, w = F.vcu & 31; if (i >= 4) break; const int pair = x * 2 + (i >> 1), sub = (i & 1) * 32 + w; uidx = pair * 64 + sub; }
        else { uidx = i * F.G + F.vcu; if (uidx >= 1024) break; }
        const int pair = uidx >> 6, sub = uidx & 63, b = pair >> 1, kvh = pair & 1, h = kvh * 4 + (sub >> 4), qb = sub & 15;
        const size_t R0 = (size_t)b * RPB + CTXL + qb * 256;
        att::attn_dense_body(QKV + R0 * NQKV + h * 128, KB + (size_t)(b * 2 + kvh) * RPB * 128, VB + (size_t)(b * 2 + kvh) * RPB * 128,
                             O + R0 * DM + h * 128, seq_, lds_generic, qb * 256, a->in[I_QN], RT, F.wave);
    }
}

constexpr int N_PHASES = 26;
enum { T_PRO = 0, T_EW = 1, T_GEMM = 2, T_SCAN = 3, T_KV = 4, T_ATTN = 5 };
__device__ __forceinline__ int phase_type(int ph) {
    if (ph == 0) return T_PRO;
    if (ph == 1 || ph == 4 || ph == 11 || ph == 14 || ph == 17 || ph == 22 || ph == 25) return T_EW;
    if (ph == 7) return T_SCAN; if (ph == 19) return T_KV; if (ph == 20) return T_ATTN;
    return T_GEMM;
}
struct GemmCfg {
    int ph; unsigned char* ws; const float* glub; int G, c, wave_s;
    __device__ __forceinline__ void opaque() { asm volatile("" : "+s"(ph)); }
    __device__ __forceinline__ void get(pg8::Gemm& g, pg8::Order& S, pg8::Epi& E) const {
        bf16_t* H = (bf16_t*)(ws + WS_H); bf16_t* BIG = (bf16_t*)(ws + WS_BIG); bf16_t* Y = (bf16_t*)(ws + WS_Y);
        g.A = H; g.Bt = nullptr; g.lda = DM; g.ldb = DM; g.K = DM; int nM = MR / 256, nN = 4, kind = 0;
        E.mode = pg8::EM_BF16; E.O = Y; E.ldc = DM; E.O2 = nullptr; E.aux = nullptr; E.bias = nullptr; E.Of = nullptr;
        if (ph == 2 || ph == 12 || ph == 15 || ph == 23) { const int q = ph == 2 ? 0 : ph == 12 ? 1 : ph == 15 ? 2 : 3; g.Bt = (const bf16_t*)(ws + WS_WFI + (size_t)q * SZ_WFI); nN = 2 * DFF / 256;
            E.mode = pg8::EM_SWIGLU; E.O = BIG; E.ldc = DFF; if (ph == 23) { nM = 128; kind = 1; } }
        else if (ph == 3 || ph == 13 || ph == 16 || ph == 24) { const int q = ph == 3 ? 0 : ph == 13 ? 1 : ph == 16 ? 2 : 3; g.A = BIG; g.lda = DFF; g.ldb = DFF; g.K = DFF; g.Bt = (const bf16_t*)(ws + WS_WFO + (size_t)q * SZ_WFO);
            if (ph == 24) { nM = 128; kind = 1; } }
        else if (ph == 5) { g.Bt = (const bf16_t*)(ws + WS_WABI); nN = NAB / 256; E.mode = pg8::EM_ABIN; E.O = BIG; E.ldc = 1536; E.O2 = (bf16_t*)(ws + WS_A2); }
        else if (ph == 6) { g.A = (const bf16_t*)(ws + WS_A2); g.lda = 512; g.Bt = (const bf16_t*)(ws + WS_B1); g.ldb = 256; g.K = 256; nM = 144; nN = 1; kind = 2; E.mode = pg8::EM_S5G1; E.Of = (float*)(ws + WS_S); }
        else if (ph == 8) { g.A = (const bf16_t*)(ws + WS_A2); g.lda = 512; g.Bt = (const bf16_t*)(ws + WS_B2); g.ldb = 512; g.K = 512; nM = 144; nN = 1; kind = 2; E.mode = pg8::EM_S5G2; E.O = (bf16_t*)(ws + WS_YB); }
        else if (ph == 9) { g.A = (const bf16_t*)(ws + WS_YB); g.lda = DB; g.Bt = (const bf16_t*)(ws + WS_WGLU); g.ldb = DB; g.K = DB; nN = 1; E.mode = pg8::EM_GLU; E.O2 = H; E.aux = (const bf16_t*)(ws + WS_YB); E.bias = glub; }
        else if (ph == 10) { g.Bt = (const bf16_t*)(ws + WS_WABO); }
        else if (ph == 18) { g.Bt = (const bf16_t*)(ws + WS_WQKV); nN = NQKV / 256; E.O = BIG; E.ldc = NQKV; }
        else { g.Bt = (const bf16_t*)(ws + WS_WAO); nM = 128; kind = 1; }
        S.init(nM, nN, G, c, kind);
    }
};
__device__ __forceinline__ void ew_cfg(int ph, KA a, Ew& e) {
    unsigned char* ws = a->ws; _Float16* XH = (_Float16*)(ws + WS_XC); const float* MOD = (const float*)(ws + WS_MOD);
    const float* npre = a->in[I_NPRE]; const float* npost = a->in[I_NPOST];
#define MODP(i, slot) (MOD + (size_t)(i) * 9 * NMODV + (slot) * DM)
    e.xl = nullptr; e.xc = nullptr; e.xh = XH; e.oh = XH; e.of = nullptr; e.Y = (const bf16_t*)(ws + WS_Y); e.gpost = nullptr; e.gate = nullptr; e.w = 0.5f; e.gpre = nullptr; e.shift = nullptr; e.scale = nullptr; e.H = (bf16_t*)(ws + WS_H); e.latent_only = 0;
    const int L = ph >= 15 ? 1 : 0;
    if (ph == 1) { e.xl = a->in[I_X]; e.xc = a->in[I_CTX]; e.oh = nullptr; e.Y = nullptr; e.gpre = npre; e.shift = MODP(0, 0); e.scale = MODP(0, 1); }
    else if (ph == 4 || ph == 17) { if (L == 0) { e.xl = a->in[I_X]; e.xc = a->in[I_CTX]; }
        e.gpost = npost + (L * 3 + 0) * DM; e.gate = MODP(L, 2); e.gpre = npre + (L * 3 + 1) * DM; e.shift = MODP(L, 3); e.scale = MODP(L, 4); }
    else if (ph == 11 || ph == 22) { e.gpost = npost + (L * 3 + 1) * DM; e.gate = MODP(L, 5); e.w = 1.0f; e.gpre = npre + (L * 3 + 2) * DM; e.shift = MODP(L, 6); e.scale = MODP(L, 7); e.latent_only = L; }
    else if (ph == 14) { e.gpost = npost + 2 * DM; e.gate = MODP(0, 8); e.gpre = npre + 3 * DM; e.shift = MODP(1, 0); e.scale = MODP(1, 1); }
    else { e.gpost = npost + 5 * DM; e.gate = MODP(1, 8); e.H = nullptr; e.oh = nullptr; e.of = a->out; e.latent_only = 1; }
#undef MODP
}
#define XB_TMO      128
#define XB_XCNT(j)  (256  + 64 * (j))
#define XB_XSUB(j)  (1280 + 64 * (j))
#define XB_XGEN(j)  (2304 + 64 * (j))
#define XB_TOP      3328
#define XB_TOPGEN   3392
#define XCD_BAR_WORDS 3456
#define XB_SPIN_CAP (1u << 20)
__device__ __forceinline__ unsigned xb_ld(unsigned* p)              { return __hip_atomic_load(p, __ATOMIC_RELAXED, __HIP_MEMORY_SCOPE_AGENT); }
__device__ __forceinline__ unsigned xb_add(unsigned* p, unsigned v) { return __hip_atomic_fetch_add(p, v, __ATOMIC_RELAXED, __HIP_MEMORY_SCOPE_AGENT); }
__device__ __forceinline__ unsigned xb_xcc_id() { return (unsigned)__builtin_amdgcn_s_getreg((3 << 11) | 20) & 0xFu; }
#define XB_SPIN(cond, bar) do { unsigned _sp = 0; while (cond) { __builtin_amdgcn_s_sleep(1); \
    if ((++_sp & 255u) == 0u) { if (xb_ld(&(bar)[XB_TMO])) break; if (_sp > XB_SPIN_CAP) { atomicAdd(&(bar)[XB_TMO], 1u); break; } } } } while (0)
__device__ __forceinline__ void xcd_barrier_complete(unsigned* bar, unsigned x, unsigned& nloc, unsigned& nx) {
    const unsigned G = gridDim.x * gridDim.y * gridDim.z;
    unsigned sum, cnt, mine, sp = 0u;
    for (;;) {
        sum = 0u; cnt = 0u; mine = 0u;
#pragma unroll
        for (unsigned j = 0; j < 16; ++j) { const unsigned c = xb_ld(&bar[XB_XCNT(j)]); sum += c; cnt += (c > 0u) ? 1u : 0u; mine = (j == x) ? c : mine; }
        if (sum == G) break;
        __builtin_amdgcn_s_sleep(1);
        if ((++sp & 255u) == 0u) { if (xb_ld(&bar[XB_TMO])) break; if (sp > XB_SPIN_CAP) { atomicAdd(&bar[XB_TMO], 1u); break; } }
    }
    nloc = mine > 0u ? mine : 1u; nx = cnt > 0u ? cnt : 1u;
}
__device__ __forceinline__ void xcd_barrier(unsigned* bar, unsigned x, volatile LAS unsigned* st, int tid) {
    asm volatile("s_waitcnt vmcnt(0)" ::: "memory");
    __syncthreads();
    if (tid == 0) {
        __builtin_amdgcn_s_waitcnt(0);
        unsigned nloc = st[0], nx = st[1];
        if (nloc == 0u) { xcd_barrier_complete(bar, x, nloc, nx); st[0] = nloc; st[1] = nx; }
        const unsigned old = xb_add(&bar[XB_XSUB(x)], 1u);
        const unsigned gen = old / nloc;
        if (old + 1u == (gen + 1u) * nloc) {
            __builtin_amdgcn_fence(__ATOMIC_RELEASE, "agent");
            asm volatile("s_waitcnt vmcnt(0)" ::: "memory");
            const unsigned og = xb_add(&bar[XB_TOP], 1u);
            const unsigned tg = og / nx;
            if (og + 1u == (tg + 1u) * nx) xb_add(&bar[XB_TOPGEN], 1u);
            else XB_SPIN(xb_ld(&bar[XB_TOPGEN]) == tg, bar);
            __builtin_amdgcn_fence(__ATOMIC_ACQUIRE, "agent");
            xb_add(&bar[XB_XGEN(x)], 1u);
            asm volatile("s_waitcnt vmcnt(0)" ::: "memory");
        } else {
            XB_SPIN(xb_ld(&bar[XB_XGEN(x)]) == gen, bar);
            __builtin_amdgcn_fence(__ATOMIC_ACQUIRE, "agent");
            asm volatile("s_waitcnt vmcnt(0)" ::: "memory");
        }
    }
    __syncthreads();
}
#ifndef PHM
#define PHM 127
#endif
#ifndef DBL_MASK
#define DBL_MASK 0u
#endif
#ifndef DBL_BAR
#define DBL_BAR 0
#endif
#define NREP(ph_) (((DBL_MASK >> (ph_)) & 1u) ? 2 : 1)
__global__ void __launch_bounds__(512, 2) mk_fwd(Args a_unused) {
    extern __shared__ __attribute__((aligned(16))) unsigned char lds[];
#if !MK_PER_PHASE
    cg::grid_group grid = cg::this_grid();
#define SEAM(ph_) do { if ((ph_) + 1 < hi) { for (int rb_ = 0; rb_ < 1 + DBL_BAR; ++rb_) { if ((ph_) == 0) grid.sync(); else xcd_barrier(xbar, xcc, (volatile LAS unsigned*)((LAS unsigned char*)lds + 131072), get_tid(wave_s)); } } } while (0)
#else
#define SEAM(ph_) do {} while (0)
#endif
    KA a0 = (KA)__builtin_amdgcn_kernarg_segment_ptr();
    const int wave_s = __builtin_amdgcn_readfirstlane((int)threadIdx.x >> 6);
    const int lo = a0->ph_lo, hi = a0->ph_hi;
    unsigned* const xbar = (unsigned*)(a0->ws + WS_BAR); const unsigned xcc = xb_xcc_id();
    if (threadIdx.x == 0) { ((volatile LAS unsigned*)((LAS unsigned char*)lds + 131072))[0] = 0u; ((volatile LAS unsigned*)((LAS unsigned char*)lds + 131072))[1] = 0u;
#if !MK_PER_PHASE
        (void)xb_add(&xbar[XB_XCNT(xcc)], 1u);
#endif
    }
    __syncthreads();
#define MKCTX() Ctx F; F.lds = (LAS unsigned char*)lds; F.tid = get_tid(wave_s); F.lane = F.tid & 63; F.wave = wave_s; \
        F.G = gridDim.x; { const int bx = blockIdx.x; F.vcu = (F.G % 8 == 0) ? (bx % 8) * (F.G / 8) + bx / 8 : bx; }
#define LIGHT_OR_GEMM(ph) do { \
        KA a = a0; asm volatile("" : "+s"(a)); \
        const int type = phase_type(ph); \
        for (int rep_ = 0; rep_ < NREP(ph); ++rep_) \
        if (type == T_EW) { if (PHM & 2) { MKCTX(); Ew e; ew_cfg(ph, a, e); ew_pass(F, e); } } \
        else if (type == T_GEMM) { \
            if (PHM & 8) { GemmCfg cfg{ph, a->ws, a->in[I_GLUB], (int)gridDim.x, (int)blockIdx.x, wave_s}; pg8::gemm_phase((LAS unsigned char*)lds, cfg); \
                if (ph == 6 && gridDim.x == 256) { MKCTX(); const int c_ = (int)blockIdx.x; const int b_ = c_ < 144 ? c_ * 6 : 864 + (c_ - 144) * 7; sgu_phase(F, a, b_, 1, b_ + (c_ < 144 ? 6 : 7)); } } \
        } else if (type == T_SCAN) { if (PHM & 16) { MKCTX(); s5_scan(F, a); if (F.G != 256) sgu_phase(F, a, F.vcu, F.G, 1 << 30); } } \
        else if (type == T_KV) { if (PHM & 32) { MKCTX(); kv_prep(F, a); } } \
        SEAM(ph); } while (0)
    if (lo <= 0 && 0 < hi) { for (int rep_ = 0; rep_ < NREP(0); ++rep_) if (PHM & 1) { KA a = a0; MKCTX(); p0_prologue(F, a); } SEAM(0); }
    { const int l1 = lo > 1 ? lo : 1, h1 = hi < 20 ? hi : 20;
      for (int ph = l1; ph < h1; ++ph) LIGHT_OR_GEMM(ph); }
    if (lo <= 20 && 20 < hi) { for (int rep_ = 0; rep_ < NREP(20); ++rep_) if (PHM & 64) { KA a = a0; MKCTX(); attn_phase(F, a, (char*)lds); } SEAM(20); }
    { const int l2 = lo > 21 ? lo : 21;
      for (int ph = l2; ph < hi; ++ph) LIGHT_OR_GEMM(ph); }
#undef MKCTX
#undef LIGHT_OR_GEMM
#undef SEAM
}

extern "C" void kernel_launch(void* const* d_in, const int* in_sizes, int n_in, void* d_out, int out_size, void* d_ws, size_t ws_size, hipStream_t stream) {
    static int grid = 0;
    if (grid == 0) {
        if (n_in != 29 || ws_size < WS_TOTAL) { fprintf(stderr, "kernel_launch: expected 29 inputs and >= %zu bytes of workspace (got %d, %zu)\n", (size_t)WS_TOTAL, n_in, ws_size); grid = -1; return; }
        int dev = 0, cus = 0, per_cu = 0;
        hipGetDevice(&dev); hipDeviceGetAttribute(&cus, hipDeviceAttributeMultiprocessorCount, dev);
        if (hipFuncSetAttribute((const void*)mk_fwd, hipFuncAttributeMaxDynamicSharedMemorySize, LDS_BYTES) != hipSuccess) { fprintf(stderr, "kernel_launch: hipFuncSetAttribute failed\n"); grid = -1; return; }
        if (hipOccupancyMaxActiveBlocksPerMultiprocessor(&per_cu, (const void*)mk_fwd, 512, LDS_BYTES) != hipSuccess || per_cu < 1) per_cu = 1;
        (void)hipGetLastError();
        grid = cus * 1;
        if (grid <= 0) grid = 256;
    }
    if (grid < 0) return;
    Args a{};
    for (int i = 0; i < 29; ++i) a.in[i] = (const float*)d_in[i];
    a.out = (float*)d_out; a.ws = (unsigned char*)d_ws;
#if MK_PER_PHASE
    for (int p = 0; p < N_PHASES; ++p) { a.ph_lo = p; a.ph_hi = p + 1; hipLaunchKernelGGL(mk_fwd, dim3(grid), dim3(512), LDS_BYTES, stream, a); }
#else
    a.ph_lo = 0; a.ph_hi = N_PHASES;
    if (hipMemsetAsync((char*)d_ws + WS_BAR, 0, 16384, stream) != hipSuccess) { fprintf(stderr, "kernel_launch: memset failed\n"); return; }
    void* args[] = {&a};
    hipError_t e = hipLaunchCooperativeKernel((const void*)mk_fwd, dim3(grid), dim3(512), args, LDS_BYTES, stream);
    if (e != hipSuccess) fprintf(stderr, "kernel_launch: cooperative launch failed: %s (grid %d)\n", hipGetErrorString(e), grid);
#endif
}
```
